# Optimizing an MI355X kernel written in HIP

```python
import math
import jax, jax.numpy as jnp
from jax import lax
import numpy as np

D_MODEL = 1024
BATCH = 1
SEQ = 16384
DEPTH = 2
DEC_BATCH = 8
DEC_SEQ = 4096
PAST_LEN = 128

HEAD_DIM = 64
FNET_WIDTH = D_MODEL // 2
FNET_GROUPS = FNET_WIDTH // HEAD_DIM
RWKV_WIDTH = D_MODEL - FNET_WIDTH
RWKV_HEADS = RWKV_WIDTH // HEAD_DIM
DECAY_LORA = 64
ICLR_LORA = 64
GATE_LORA = 128
R_OFF = 0
K_OFF = RWKV_WIDTH
V_OFF = 2 * RWKV_WIDTH
WD_OFF = 3 * RWKV_WIDTH
AD_OFF = WD_OFF + 2 * DECAY_LORA
GD_OFF = AD_OFF + 2 * ICLR_LORA
RWKV_IN = GD_OFF + GATE_LORA
MIX0_IN = FNET_WIDTH + RWKV_IN
GN_EPS = 64e-5
DIFF_HEADS = D_MODEL // (2 * HEAD_DIM)
DIFF_QK_DIM = HEAD_DIM
DIFF_V_DIM = 2 * HEAD_DIM
DIFF_Q_WIDTH = DIFF_HEADS * 2 * DIFF_QK_DIM
DIFF_V_WIDTH = DIFF_HEADS * DIFF_V_DIM
ROPE_THETA = 10000.0
Q_BLOCK = 128
SUBLN_EPS = 1e-5
D_FF = (11 * D_MODEL) // 4
CONV_W = 3
NORM_EPS = 1e-6
N_EVEN = (DEPTH + 1) // 2
N_ODD = DEPTH // 2

kernel_name = "fnet_rwkv7_diffattn_convffn_encoder"


def rms_norm(x, g, eps=NORM_EPS):
    xf = x.astype(jnp.float32)
    y = xf * lax.rsqrt(jnp.mean(xf * xf, axis=-1, keepdims=True) + eps)
    return (y * g.astype(jnp.float32)).astype(x.dtype)


def shift_prev(z):
    return jnp.pad(z[:, :-1], ((0, 0), (1, 0), (0, 0)))


def shift_next(z):
    return jnp.pad(z[:, 1:], ((0, 0), (0, 1), (0, 0)))


def rotary(x):
    s_len, dim = x.shape[1], x.shape[-1]
    half = dim // 2
    inv_freq = ROPE_THETA ** (-jnp.arange(half, dtype=jnp.float32) / half)
    ang = jnp.arange(s_len, dtype=jnp.float32)[:, None] * inv_freq[None, :]
    bshape = (1, s_len) + (1,) * (x.ndim - 3) + (half,)
    cos = jnp.cos(ang).reshape(bshape)
    sin = jnp.sin(ang).reshape(bshape)
    xf = x.astype(jnp.float32)
    x1, x2 = xf[..., :half], xf[..., half:]
    return jnp.concatenate([x1 * cos - x2 * sin, x2 * cos + x1 * sin], axis=-1).astype(x.dtype)


def to_heads(t):
    return t.reshape(t.shape[:-1] + (RWKV_HEADS, HEAD_DIM))


def wkv7_scan(r, decay, k, v, a, b):
    bsz, _, nh, n = r.shape

    def step(state, inp):
        r_t, w_t, k_t, v_t, a_t, b_t = inp
        sa = jnp.einsum('bhvk,bhk->bhv', state, a_t)
        state = (state * w_t[:, :, None, :] + sa[..., None] * b_t[:, :, None, :]
                 + v_t[..., None] * k_t[:, :, None, :])
        y = jnp.einsum('bhvk,bhk->bhv', state, r_t)
        return state, y

    xs = tuple(jnp.swapaxes(t, 0, 1) for t in (r, decay, k, v, a, b))
    s0 = jnp.zeros((bsz, nh, n, n), jnp.float32)
    _, y = lax.scan(step, s0, xs)
    return jnp.swapaxes(y, 0, 1)


def rwkv7_bidirectional(z, w0, w2, a0, a2, g2, k_k, k_a, r_k, lnx_g, lnx_b):
    bsz, s_len, _ = z.shape
    f32 = jnp.float32
    zf = z.astype(f32)
    r = zf[..., R_OFF:R_OFF + RWKV_WIDTH]
    k = zf[..., K_OFF:K_OFF + RWKV_WIDTH]
    v = zf[..., V_OFF:V_OFF + RWKV_WIDTH]
    wd = zf[..., WD_OFF:AD_OFF].reshape(bsz, s_len, 2, DECAY_LORA)
    ad = zf[..., AD_OFF:GD_OFF].reshape(bsz, s_len, 2, ICLR_LORA)
    gd = zf[..., GD_OFF:RWKV_IN]
    w_log = -jax.nn.softplus(-(w0.astype(f32) + jnp.einsum('bsdr,drc->bsdc', jnp.tanh(wd), w2.astype(f32)))) - 0.5
    decay = jnp.exp(-jnp.exp(w_log))
    iclr = jax.nn.sigmoid(a0.astype(f32) + jnp.einsum('bsdr,drc->bsdc', ad, a2.astype(f32)))
    gate = jax.nn.sigmoid(gd) @ g2.astype(f32)
    kk = to_heads(k * k_k.astype(f32))
    kk = kk / jnp.maximum(jnp.sqrt(jnp.sum(kk * kk, axis=-1, keepdims=True)), 1e-12)
    r_h, v_h = to_heads(r), to_heads(v)
    r_kf = r_k.astype(f32)
    y = jnp.zeros_like(r_h)
    bonus = jnp.zeros((bsz, s_len, RWKV_HEADS, 1), f32)
    for d in range(2):
        a_d = to_heads(iclr[:, :, d])
        k_d = to_heads(k * (1.0 + (iclr[:, :, d] - 1.0) * k_a.astype(f32)))
        ins = (r_h, to_heads(decay[:, :, d]), k_d, v_h, -kk, kk * a_d)
        if d == 1:
            ins = tuple(t[:, ::-1] for t in ins)
        y_d = wkv7_scan(*ins)
        if d == 1:
            y_d = y_d[:, ::-1]
        y = y + y_d
        bonus = bonus + jnp.sum(r_h * k_d * r_kf, axis=-1, keepdims=True)
    mu = jnp.mean(y, axis=-1, keepdims=True)
    var = jnp.mean(jnp.square(y - mu), axis=-1, keepdims=True)
    yn = ((y - mu) * lax.rsqrt(var + GN_EPS)).reshape(bsz, s_len, RWKV_WIDTH)
    yn = yn * lnx_g.astype(f32) + lnx_b.astype(f32)
    out = (yn + (bonus * v_h).reshape(bsz, s_len, RWKV_WIDTH)) * gate
    return out.astype(z.dtype)


def fourier_rwkv_mixer(h, w_in, mu_prev, mu_next, w0, w2, a0, a2, g2, k_k, k_a, r_k, lnx_g, lnx_b, w_out):
    bsz, s_len, _ = h.shape
    z = h @ w_in
    u = z[..., :FNET_WIDTH]
    zr = z[..., FNET_WIDTH:]
    zr = zr + mu_prev * (shift_prev(zr) - zr) + mu_next * (shift_next(zr) - zr)
    ug = u.astype(jnp.float32).reshape(bsz, s_len, FNET_GROUPS, HEAD_DIM)
    f = jnp.fft.fft2(ug, axes=(1, 3), norm='ortho').real
    f = f.reshape(bsz, s_len, FNET_WIDTH).astype(h.dtype)
    y_rwkv = rwkv7_bidirectional(zr, w0, w2, a0, a2, g2, k_k, k_a, r_k, lnx_g, lnx_b)
    return jnp.concatenate([f, y_rwkv], axis=-1) @ w_out


def diff_attention(h, w_qkv, lq1, lk1, lq2, lk2, subln_g, w_o, lambda_init):
    bsz, s_len, _ = h.shape
    f32 = jnp.float32
    qkv = h @ w_qkv
    q = qkv[..., :DIFF_Q_WIDTH].reshape(bsz, s_len, DIFF_HEADS, 2, DIFF_QK_DIM)
    k = qkv[..., DIFF_Q_WIDTH:2 * DIFF_Q_WIDTH].reshape(bsz, s_len, DIFF_HEADS, 2, DIFF_QK_DIM)
    v = qkv[..., 2 * DIFF_Q_WIDTH:].reshape(bsz, s_len, DIFF_HEADS, DIFF_V_DIM)
    q = rotary(q) * (DIFF_QK_DIM ** -0.5)
    k = rotary(k)
    lam = (jnp.exp(jnp.sum(lq1.astype(f32) * lk1.astype(f32)))
           - jnp.exp(jnp.sum(lq2.astype(f32) * lk2.astype(f32))) + lambda_init)
    n_blk = s_len // Q_BLOCK
    qb = jnp.moveaxis(q.reshape(bsz, n_blk, Q_BLOCK, DIFF_HEADS, 2, DIFF_QK_DIM), 1, 0)

    def block(q_blk):
        s = jnp.einsum('bqhcd,bkhcd->bhcqk', q_blk, k).astype(f32)
        p = jax.nn.softmax(s, axis=-1)
        attn = (p[:, :, 0] - lam * p[:, :, 1]).astype(v.dtype)
        return jnp.einsum('bhqk,bkhe->bqhe', attn, v)

    o = lax.map(block, qb)
    o = jnp.moveaxis(o, 0, 1).reshape(bsz, s_len, DIFF_HEADS, DIFF_V_DIM)
    o = rms_norm(o, subln_g, SUBLN_EPS) * (1.0 - lambda_init)
    return o.reshape(bsz, s_len, DIFF_V_WIDTH) @ w_o


def conv_ffn(h, w_up, conv_w, conv_b, w_down):
    u = h @ w_up
    u = conv_w[0] * shift_prev(u) + conv_w[1] * u + conv_w[2] * shift_next(u) + conv_b
    val, gate = u[..., :D_FF], u[..., D_FF:]
    return (jax.nn.gelu(gate, approximate=True) * val) @ w_down


def setup_inputs(seed: int = 0) -> dict:
    key = jax.random.key(seed)
    ks = iter(jax.random.split(key, 48))
    f32 = jnp.float32

    def nrm(shape, scale):
        return scale * jax.random.normal(next(ks), shape, f32)

    def gain(shape):
        return 1.0 + 0.05 * jax.random.normal(next(ks), shape, f32)

    return {
        'x_prompt': nrm((BATCH, SEQ, D_MODEL), 1.0),
        'x_sample': nrm((DEC_BATCH, DEC_SEQ, D_MODEL), 1.0),
        'mix0_norm_pre': gain((N_EVEN, D_MODEL)),
        'mix0_norm_post': gain((N_EVEN, D_MODEL)),
        'w_in0': nrm((N_EVEN, D_MODEL, MIX0_IN), D_MODEL ** -0.5),
        'mu_prev': jax.random.uniform(next(ks), (N_EVEN, RWKV_IN), f32, 0.0, 0.5),
        'mu_next': jax.random.uniform(next(ks), (N_EVEN, RWKV_IN), f32, 0.0, 0.5),
        'decay_w0': jax.random.uniform(next(ks), (N_EVEN, 2, RWKV_WIDTH), f32, -5.0, 1.0),
        'decay_w2': nrm((N_EVEN, 2, DECAY_LORA, RWKV_WIDTH), 0.5 * DECAY_LORA ** -0.5),
        'iclr_a0': nrm((N_EVEN, 2, RWKV_WIDTH), 0.1),
        'iclr_a2': nrm((N_EVEN, 2, ICLR_LORA, RWKV_WIDTH), 0.5 * ICLR_LORA ** -0.5),
        'gate_g2': nrm((N_EVEN, GATE_LORA, RWKV_WIDTH), GATE_LORA ** -0.5),
        'k_k': 0.85 + nrm((N_EVEN, RWKV_WIDTH), 0.05),
        'k_a': 1.0 + nrm((N_EVEN, RWKV_WIDTH), 0.05),
        'r_k': nrm((N_EVEN, RWKV_HEADS, HEAD_DIM), 0.1),
        'lnx_g': gain((N_EVEN, RWKV_WIDTH)),
        'lnx_b': nrm((N_EVEN, RWKV_WIDTH), 0.01),
        'w_out0': nrm((N_EVEN, D_MODEL, D_MODEL), D_MODEL ** -0.5),
        'mix1_norm_pre': gain((N_ODD, D_MODEL)),
        'mix1_norm_post': gain((N_ODD, D_MODEL)),
        'w_qkv1': nrm((N_ODD, D_MODEL, 2 * DIFF_Q_WIDTH + DIFF_V_WIDTH), D_MODEL ** -0.5),
        'lambda_q1': nrm((N_ODD, DIFF_QK_DIM), 0.1),
        'lambda_k1': nrm((N_ODD, DIFF_QK_DIM), 0.1),
        'lambda_q2': nrm((N_ODD, DIFF_QK_DIM), 0.1),
        'lambda_k2': nrm((N_ODD, DIFF_QK_DIM), 0.1),
        'subln_g': gain((N_ODD, DIFF_V_DIM)),
        'w_o1': nrm((N_ODD, DIFF_V_WIDTH, D_MODEL), DIFF_V_WIDTH ** -0.5),
        'ffn_norm_pre': gain((DEPTH, D_MODEL)),
        'ffn_norm_post': gain((DEPTH, D_MODEL)),
        'w_up': nrm((DEPTH, D_MODEL, 2 * D_FF), D_MODEL ** -0.5),
        'conv_w': nrm((DEPTH, CONV_W, 2 * D_FF), CONV_W ** -0.5),
        'conv_b': nrm((DEPTH, 2 * D_FF), 0.01),
        'w_down': nrm((DEPTH, D_FF, D_MODEL), D_FF ** -0.5),
    }


def reference(x_prompt, x_sample,
              mix0_norm_pre, mix0_norm_post, w_in0, mu_prev, mu_next, decay_w0, decay_w2,
              iclr_a0, iclr_a2, gate_g2, k_k, k_a, r_k, lnx_g, lnx_b, w_out0,
              mix1_norm_pre, mix1_norm_post, w_qkv1, lambda_q1, lambda_k1, lambda_q2, lambda_k2,
              subln_g, w_o1,
              ffn_norm_pre, ffn_norm_post, w_up, conv_w, conv_b, w_down):
    def trunk(x):
        for layer in range(DEPTH):
            if layer % 2 == 0:
                i = layer // 2
                h = rms_norm(x, mix0_norm_pre[i])
                h = fourier_rwkv_mixer(h, w_in0[i], mu_prev[i], mu_next[i], decay_w0[i], decay_w2[i],
                                       iclr_a0[i], iclr_a2[i], gate_g2[i], k_k[i], k_a[i], r_k[i],
                                       lnx_g[i], lnx_b[i], w_out0[i])
                x = x + rms_norm(h, mix0_norm_post[i])
            else:
                i = layer // 2
                lambda_init = 0.8 - 0.6 * math.exp(-0.3 * layer)
                h = rms_norm(x, mix1_norm_pre[i])
                h = diff_attention(h, w_qkv1[i], lambda_q1[i], lambda_k1[i], lambda_q2[i], lambda_k2[i],
                                   subln_g[i], w_o1[i], lambda_init)
                x = x + rms_norm(h, mix1_norm_post[i])
            h = rms_norm(x, ffn_norm_pre[layer])
            h = conv_ffn(h, w_up[layer], conv_w[layer], conv_b[layer], w_down[layer])
            x = x + rms_norm(h, ffn_norm_post[layer])
        return x

    y_prompt = trunk(x_prompt)
    y_sample = trunk(x_sample)
    return (y_prompt, y_sample)
```

```cpp
#include <hip/hip_runtime.h>
#include <hip/hip_cooperative_groups.h>
#include <cstdio>
#include <cstdint>
namespace cg = cooperative_groups;

#define DI __device__ __forceinline__
#define LAS __attribute__((address_space(3)))
typedef unsigned short bf16_t;
typedef short bf16x8 __attribute__((ext_vector_type(8)));
typedef short s16x4 __attribute__((ext_vector_type(4)));
typedef float f32x2 __attribute__((ext_vector_type(2)));
typedef float f32x4 __attribute__((ext_vector_type(4)));
typedef float f32x16 __attribute__((ext_vector_type(16)));
typedef unsigned u32x2 __attribute__((ext_vector_type(2)));
typedef unsigned u32x4 __attribute__((ext_vector_type(4)));

constexpr int T = 49152, DM = 1024, TPR = 16384, SL = 4096;
constexpr int NIN = 2560;
constexpr int ZR = 1920, MIXIN = 2432;
constexpr int FF = 2816, NUP = 5632;
constexpr int NBLK = 256;
constexpr float LAMBDA_INIT = 0.35550906759f;

constexpr size_t MiB = 1u << 20;
constexpr size_t WS_WIN = 1 * MiB, WS_WG = 7 * MiB, WS_WOUT0 = 8 * MiB, WS_WUP = 10 * MiB, WS_WDN = 32 * MiB, WS_WQKV = 43 * MiB, WS_WO = 49 * MiB;
constexpr size_t WS_ROPE = 51 * MiB, WS_BONUS = 55 * MiB, WS_DFT = 58 * MiB, WS_HNRAW = 122 * MiB, WS_B = 220 * MiB, WS_END = 512 * MiB;
constexpr size_t WS_HN = WS_HNRAW + 256 * 2048;
constexpr size_t WS_RKV = WS_B, WS_LD = WS_B + 144 * MiB, WS_GATE = WS_B + 180 * MiB, WS_YC = WS_B + 228 * MiB;
constexpr size_t WS_RAWB = WS_B, WS_ACT = WS_B, WS_Q = WS_B, WS_K = WS_B + 96 * MiB, WS_V = WS_B + 192 * MiB;
constexpr size_t WS_ATMP = WS_DFT;
constexpr size_t DO_UTS = 0, DO_UTP = 64 * MiB, DO_YF = 0, DO_YB = 48 * MiB, DO_SC = 146 * MiB, DO_SS = 166 * MiB;

constexpr int LDS_BYTES = 148480;
#ifndef PHMASK
#define PHMASK 0xFFFF
#endif
#define PH(k) ((PHMASK >> (k)) & 1)
#ifndef DUPMASK
#define DUPMASK 0
#endif
#define REP(k) for (int rep_ = 0; rep_ < 1 + ((DUPMASK >> (k)) & 1); ++rep_)

struct Args { const float* in[33]; float* out; unsigned char* ws; };

DI unsigned cvtpk(float lo, float hi) { unsigned r; asm volatile("v_cvt_pk_bf16_f32 %0, %1, %2" : "=v"(r) : "v"(lo), "v"(hi)); return r; }
DI unsigned short f2bf(float f) { return (unsigned short)(cvtpk(f, f) & 0xffffu); }
DI float bf2f(unsigned h) { return __uint_as_float(h << 16); }
DI float bflo(unsigned w) { return __uint_as_float(w << 16); }
DI float bfhi(unsigned w) { return __uint_as_float(w & 0xffff0000u); }
DI float dppf(float v, const int ctrl) { return v; }
#define DPPF(v, ctrl) __builtin_bit_cast(float, __builtin_amdgcn_update_dpp(0, __builtin_bit_cast(int, (v)), (ctrl), 0xf, 0xf, true))
DI float red8(float v) { v += DPPF(v, 0xB1); v += DPPF(v, 0x4E); v += DPPF(v, 0x141); return v; }
DI float red16(float v) { v = red8(v); v += DPPF(v, 0x128); return v; }
DI float wave_sum(float v) {
#pragma unroll
    for (int o = 1; o < 64; o <<= 1) v += __shfl_xor(v, o);
    return v;
}
DI float sigmoidf_(float x) { return __builtin_amdgcn_rcpf(1.f + __expf(-x)); }
DI bool is_first(int t) { return t == 0 || (t >= TPR && (t & (SL - 1)) == 0); }
DI bool is_last(int t) { return t == TPR - 1 || (t >= TPR && (t & (SL - 1)) == SL - 1); }
DI int seq_pos(int t) { return t < TPR ? t : (t & (SL - 1)); }
DI const float* xin_row(const float* xp, const float* xs, int t) { return t < TPR ? xp + (size_t)t * DM : xs + (size_t)(t - TPR) * DM; }

namespace pg8 {
constexpr int BM = 256, BK = 64, HALF = 128, HTB = HALF * BK * 2, NXCD = 8, WGM = 8;
DI int lds_byte(int r, int c) { const int st = (r >> 4) * 2 + (c >> 5), rr = r & 15, cc = c & 31, ob = rr * 64 + cc * 2; return st * 1024 + (ob ^ (((ob >> 9) & 1) << 5)); }
DI void stage_rc(int b, int& R, int& C) { const int st = b / 1024, sb = b % 1024, swz = sb ^ (((sb >> 9) & 1) << 5); R = (st >> 1) * 16 + swz / 64; C = (st & 1) * 32 + (swz % 64) / 2; }
DI int perm32(int rho) { const int n = rho >> 4, i = rho & 15; return 8 * (i >> 2) + 4 * n + (i & 3); }

struct Unit { int pm, pn; };
struct Gemm { const bf16_t* A; const bf16_t* Bt; int K, lda, ldb; };

struct Sched {
    int nM, nN, nwg, G, c, tpb; size_t a_tstep, b_tstep, b_batch;
    DI void init(int nM_, int nN_, int G_, int c_, size_t a_tstep_, size_t b_tstep_, int tpb_, size_t b_batch_) {
        nM = nM_; nN = nN_; nwg = nM * nN; G = G_; c = c_; a_tstep = a_tstep_; b_tstep = b_tstep_; tpb = tpb_; b_batch = b_batch_; }
    DI bool next(int i, Unit& u) const {
        const long L = (long)i * G + c; if (L >= nwg) return false;
        int wgid = (int)L; { const int q = nwg / NXCD, r = nwg % NXCD, xcd = wgid % NXCD, off = wgid / NXCD; wgid = (xcd < r ? xcd * (q + 1) : r * (q + 1) + (xcd - r) * q) + off; }
        const int nig = WGM * nN, gid = wgid / nig, fm = gid * WGM, gsz = (nM - fm) < WGM ? (nM - fm) : WGM;
        u.pm = fm + ((wgid % nig) % gsz); u.pn = (wgid % nig) / gsz; return true;
    }
    DI size_t aoff(const Unit& u) const { return (size_t)(u.pm % tpb) * a_tstep; }
    DI size_t boff(const Unit& u) const { return (size_t)(u.pm / tpb) * b_batch + (size_t)u.pn * b_tstep; }
};

template <class Epi, int OVL>
DI void gemm_phase(LAS unsigned char* lds, const Gemm g, const Sched& S, const Epi& E) {
    int tid_ = threadIdx.x; asm volatile("" : "+v"(tid_));
    const int tid = tid_, wid = __builtin_amdgcn_readfirstlane(tid >> 6), lane = tid & 63, wr = wid >> 2, wc = wid & 3, fr = lane & 15, fq = lane >> 4;
    const int K = g.K, nt = K / BK;
    unsigned voffA[2], voffB[2];
#pragma unroll
    for (int i = 0; i < 2; ++i) { int R, C; stage_rc(tid * 16 + i * 8192, R, C); const int Rb = (R & ~31) + perm32(R & 31);
        const int Ra = OVL ? ((R >> 6) * 62 + (R & 63)) : R;
        voffA[i] = (unsigned)(Ra * g.lda + C) * 2u; voffB[i] = (unsigned)(Rb * g.ldb + C) * 2u; }
    const size_t kstep = (size_t)(BK * 2);
    const size_t hstepA = (size_t)(OVL ? 124 : 128) * g.lda * 2, hstepB = (size_t)HALF * g.ldb * 2;
    const unsigned ldsw = (unsigned)wid * 1024u;
    const int aoff = lds_byte(wr * 64 + fr, fq * 8), boff = lds_byte(wc * 32 + fr, fq * 8);
#define PG8_SA(b, h) (((b) * 2 + (h)) * HTB)
#define PG8_SB(b, h) ((4 + (b) * 2 + (h)) * HTB)
#define PG8_STAGE(bufoff, gbase, voff) do { _Pragma("unroll") for (int _i = 0; _i < 2; ++_i) \
        __builtin_amdgcn_global_load_lds((const unsigned*)((const char*)(gbase) + (voff)[_i]), (LAS unsigned*)(lds + (bufoff) + ldsw + _i * 8192), 16, 0, 0); } while (0)
#define PG8_LDA(dst, b, h) do { _Pragma("unroll") for (int m = 0; m < 4; ++m) _Pragma("unroll") for (int k = 0; k < 2; ++k) dst[m][k] = *(const LAS bf16x8*)(lds + PG8_SA(b, h) + aoff + m * 2048 + k * 1024); } while (0)
#define PG8_LDB(dst, b, h) do { _Pragma("unroll") for (int n = 0; n < 2; ++n) _Pragma("unroll") for (int k = 0; k < 2; ++k) dst[n][k] = *(const LAS bf16x8*)(lds + PG8_SB(b, h) + boff + n * 2048 + k * 1024); } while (0)
#define PG8_MMA(ai, bj, At, Bt) do { __builtin_amdgcn_s_setprio(1); _Pragma("unroll") for (int m = 0; m < 4; ++m) _Pragma("unroll") for (int n = 0; n < 2; ++n) _Pragma("unroll") for (int k = 0; k < 2; ++k) \
        acc[ai][bj][m][n] = __builtin_amdgcn_mfma_f32_16x16x32_bf16(Bt[n][k], At[m][k], acc[ai][bj][m][n], 0, 0, 0); __builtin_amdgcn_s_setprio(0); } while (0)
#define PG8_WAIT_V(n) asm volatile("s_waitcnt vmcnt(" #n ")" ::: "memory")
#define PG8_WAIT_L(n) asm volatile("s_waitcnt lgkmcnt(" #n ")" ::: "memory")
#define PG8_BAR __builtin_amdgcn_s_barrier()
#define PG8_SCHED __builtin_amdgcn_sched_barrier(0)
    Unit cur, nxt; int ui = 0;
    if (!S.next(0, cur)) return;
    f32x4 acc[2][2][4][2];
#pragma unroll
    for (int a = 0; a < 2; ++a)
#pragma unroll
        for (int b = 0; b < 2; ++b)
#pragma unroll
            for (int m = 0; m < 4; ++m)
#pragma unroll
                for (int n = 0; n < 2; ++n) acc[a][b][m][n] = (f32x4){0.f, 0.f, 0.f, 0.f};
    bf16x8 At[4][2], B0[2][2], B1[2][2];
    const char* cA = (const char*)g.A + S.aoff(cur); const char* cB = (const char*)g.Bt + S.boff(cur);
    PG8_STAGE(PG8_SB(0, 0), cB, voffB); PG8_STAGE(PG8_SB(0, 1), cB + hstepB, voffB); PG8_STAGE(PG8_SA(0, 0), cA, voffA); PG8_STAGE(PG8_SA(0, 1), cA + hstepA, voffA);
    if (wr == 1) PG8_BAR;
    PG8_WAIT_V(2); PG8_BAR;
    PG8_STAGE(PG8_SB(1, 0), cB + kstep, voffB); PG8_STAGE(PG8_SA(1, 0), cA + kstep, voffA); PG8_STAGE(PG8_SB(1, 1), cB + hstepB + kstep, voffB);
    PG8_WAIT_V(6); PG8_BAR;
    for (;;) {
        const bool has_next = S.next(ui + 1, nxt);
        const char* nA = has_next ? (const char*)g.A + S.aoff(nxt) : cA; const char* nB = has_next ? (const char*)g.Bt + S.boff(nxt) : cB;
        for (int t = 0; t < nt; t += 2) {
            const bool last = (t == nt - 2);
            const char* a1 = cA + (size_t)(t + 1) * kstep;
            const char* a2 = last ? nA : cA + (size_t)(t + 2) * kstep; const char* b2 = last ? nB : cB + (size_t)(t + 2) * kstep;
            const char* a3 = a2 + kstep; const char* b3 = b2 + kstep;
            PG8_LDB(B0, 0, 0); PG8_LDB(B1, 0, 1); PG8_SCHED; PG8_LDA(At, 0, 0); PG8_STAGE(PG8_SA(1, 1), a1 + hstepA, voffA);
            PG8_WAIT_V(8); PG8_WAIT_L(0); PG8_BAR; PG8_MMA(0, 0, At, B0); PG8_MMA(0, 1, At, B1); PG8_BAR; PG8_SCHED;
            PG8_LDA(At, 0, 1); PG8_STAGE(PG8_SB(0, 0), b2, voffB); PG8_STAGE(PG8_SB(0, 1), b2 + hstepB, voffB); PG8_STAGE(PG8_SA(0, 0), a2, voffA);
            PG8_WAIT_V(8); PG8_WAIT_L(0); PG8_BAR; PG8_MMA(1, 0, At, B0); PG8_MMA(1, 1, At, B1); PG8_BAR; PG8_SCHED;
            PG8_LDB(B0, 1, 0); PG8_LDB(B1, 1, 1); PG8_SCHED; PG8_LDA(At, 1, 0); PG8_STAGE(PG8_SA(0, 1), a2 + hstepA, voffA);
            PG8_WAIT_V(8); PG8_WAIT_L(0); PG8_BAR; PG8_MMA(0, 0, At, B0); PG8_MMA(0, 1, At, B1); PG8_BAR; PG8_SCHED;
            PG8_LDA(At, 1, 1); PG8_STAGE(PG8_SB(1, 0), b3, voffB); PG8_STAGE(PG8_SB(1, 1), b3 + hstepB, voffB); PG8_STAGE(PG8_SA(1, 0), a3, voffA);
            PG8_WAIT_V(8); PG8_WAIT_L(0); PG8_BAR; PG8_MMA(1, 0, At, B0); PG8_MMA(1, 1, At, B1); PG8_BAR; PG8_SCHED;
        }
        if (wr == 0) PG8_BAR;
        E(acc, cur, wr, wc, fr, fq);
        if (!has_next) break;
#pragma unroll
        for (int a = 0; a < 2; ++a)
#pragma unroll
            for (int b = 0; b < 2; ++b)
#pragma unroll
                for (int m = 0; m < 4; ++m)
#pragma unroll
                    for (int n = 0; n < 2; ++n) acc[a][b][m][n] = (f32x4){0.f, 0.f, 0.f, 0.f};
        cur = nxt; cA = nA; cB = nB; ++ui;
        if (wr == 1) PG8_BAR;
    }
    PG8_WAIT_V(0);
    PG8_BAR;
#undef PG8_SA
#undef PG8_SB
#undef PG8_STAGE
#undef PG8_LDA
#undef PG8_LDB
#undef PG8_MMA
#undef PG8_WAIT_V
#undef PG8_WAIT_L
#undef PG8_BAR
#undef PG8_SCHED
}

struct EpiStore {
    bf16_t* O; int ldc; int row_off; float scale;
    DI void operator()(const f32x4 (&acc)[2][2][4][2], const Unit& u, int wr, int wc, int fr, int fq) const {
        const int row0 = row_off + u.pm * BM + wr * 64 + fr, col0 = u.pn * BM + wc * 32 + 8 * fq;
#pragma unroll
        for (int ai = 0; ai < 2; ++ai)
#pragma unroll
            for (int m = 0; m < 4; ++m) { bf16_t* rowp = O + (size_t)(row0 + ai * HALF + m * 16) * ldc + col0;
#pragma unroll
                for (int bj = 0; bj < 2; ++bj) { const f32x4 v0 = acc[ai][bj][m][0] * scale, v1 = acc[ai][bj][m][1] * scale;
                    u32x4 w; w.x = cvtpk(v0[0], v0[1]); w.y = cvtpk(v0[2], v0[3]); w.z = cvtpk(v1[0], v1[1]); w.w = cvtpk(v1[2], v1[3]);
                    *(u32x4*)(rowp + bj * HALF) = w; } }
    }
};

DI f32x4 shfl4(f32x4 v, int src) { f32x4 r; r.x = __shfl(v.x, src); r.y = __shfl(v.y, src); r.z = __shfl(v.z, src); r.w = __shfl(v.w, src); return r; }

#define CONV_COL(ACC, AI, BJ, N, Z, CP, CM, CN) do { const f32x4 zero4_ = {0.f, 0.f, 0.f, 0.f}; \
    _Pragma("unroll") for (int m = 0; m < 4; ++m) { const f32x4 cur_ = ACC[AI][BJ][m][N]; \
        const f32x4 su_ = (fr == 15) ? (m > 0 ? ACC[AI][BJ][m > 0 ? m - 1 : 0][N] : zero4_) : cur_; \
        const f32x4 sd_ = (fr == 0) ? (m < 3 ? ACC[AI][BJ][m < 3 ? m + 1 : 3][N] : zero4_) : cur_; \
        f32x4 up_ = shfl4(su_, src_up), dn_ = shfl4(sd_, src_dn); \
        const int t_ = tok0 + 16 * m + fr; \
        if (is_first(t_)) up_ = zero4_; if (is_last(t_)) dn_ = zero4_; \
        Z[m] = CP * up_ + CM * cur_ + CN * dn_; } } while (0)
#define CONV_ONE(ACC, AI, BJ, N, M, Z, CP, CM, CN) do { const f32x4 zero4_ = {0.f, 0.f, 0.f, 0.f}; const f32x4 cur_ = ACC[AI][BJ][M][N]; \
        const f32x4 su_ = (fr == 15) ? (M > 0 ? ACC[AI][BJ][M > 0 ? M - 1 : 0][N] : zero4_) : cur_; \
        const f32x4 sd_ = (fr == 0) ? (M < 3 ? ACC[AI][BJ][M < 3 ? M + 1 : 3][N] : zero4_) : cur_; \
        f32x4 up_ = shfl4(su_, src_up), dn_ = shfl4(sd_, src_dn); \
        const int t_ = tok0 + 16 * M + fr; \
        if (is_first(t_)) up_ = zero4_; if (is_last(t_)) dn_ = zero4_; \
        Z = CP * up_ + CM * cur_ + CN * dn_; } while (0)
#define ROW_VALID(m) ((16 * (m) + fr >= 1) && (16 * (m) + fr <= 62) && (tok0 + 16 * (m) + fr < T))

struct EpiIn {
    const float* mu_prev; const float* mu_next; bf16_t* UTS_; bf16_t* UTP_; bf16_t* RKV_; bf16_t* LD_;
    DI void operator()(const f32x4 (&acc)[2][2][4][2], const Unit& u, int wr, int wc, int fr_, int fq_) const {
        int fr = fr_, fq = fq_; asm volatile("" : "+v"(fr), "+v"(fq));
        const int lane = fr | (fq << 4);
        const int src_up = (lane & 48) | ((fr + 15) & 15), src_dn = (lane & 48) | ((fr + 1) & 15);
        if (u.pn < 2) {
#pragma unroll
            for (int ai = 0; ai < 2; ++ai) {
                const int tok0 = u.pm * 248 + (2 * ai + wr) * 62 - 1;
#pragma unroll
                for (int m = 0; m < 4; ++m) {
                    if (ROW_VALID(m)) { const int t = tok0 + 16 * m + fr; const bool smp = t >= TPR;
                        const int s_ = smp ? (t & (SL - 1)) : (t >> 2); const int rb = (smp ? 4 + ((t - TPR) >> 12) : (t & 3)) * 512;
#pragma unroll
                        for (int bj = 0; bj < 2; ++bj) { const int c0 = u.pn * BM + bj * HALF + wc * 32 + 8 * fq;
#pragma unroll
                            for (int n = 0; n < 2; ++n)
#pragma unroll
                                for (int e = 0; e < 4; ++e) UTS_[((size_t)(rb + c0 + 4 * n + e)) * 4096 + s_] = f2bf(acc[ai][bj][m][n][e]); }
                    }
                    __builtin_amdgcn_sched_barrier(0); }
            }
        } else {
#pragma unroll
            for (int bj = 0; bj < 2; ++bj) {
                const int zc0 = u.pn * BM + bj * HALF + wc * 32 + 8 * fq - 512;
                if (zc0 >= ZR) continue;
                const int act = zc0 < 1536 ? 0 : (zc0 < 1664 ? 1 : (zc0 < 1792 ? 0 : 2));
#pragma unroll
                for (int n = 0; n < 2; ++n) { const f32x4 cp = *(const f32x4*)(mu_prev + zc0 + 4 * n), cn = *(const f32x4*)(mu_next + zc0 + 4 * n); const f32x4 cm = 1.f - cp - cn;
#pragma unroll
                    for (int ai = 0; ai < 2; ++ai) {
                        const int tok0 = u.pm * 248 + (2 * ai + wr) * 62 - 1;
#pragma unroll
                        for (int m = 0; m < 4; ++m) { f32x4 z;
                            CONV_ONE(acc, ai, bj, n, m, z, cp, cm, cn);
                            if (act == 1) {
#pragma unroll
                                for (int e = 0; e < 4; ++e) z[e] = 1.f - 2.f * __builtin_amdgcn_rcpf(1.f + __expf(2.f * z[e])); }
                            if (act == 2) {
#pragma unroll
                                for (int e = 0; e < 4; ++e) z[e] = sigmoidf_(z[e]); }
                            if (ROW_VALID(m)) { const int t = tok0 + 16 * m + fr; u32x2 w; w.x = cvtpk(z[0], z[1]); w.y = cvtpk(z[2], z[3]);
                                if (zc0 < 1536) *(u32x2*)(RKV_ + (size_t)t * 1536 + zc0 + 4 * n) = w; else *(u32x2*)(LD_ + (size_t)t * 384 + (zc0 - 1536) + 4 * n) = w; }
                            __builtin_amdgcn_sched_barrier(0); }
                    }
                }
            }
        }
    }
};

struct EpiUp {
    const float* cw; const float* cb; bf16_t* ACT;
    DI void operator()(const f32x4 (&acc)[2][2][4][2], const Unit& u, int wr, int wc, int fr_, int fq_) const {
        int fr = fr_, fq = fq_; asm volatile("" : "+v"(fr), "+v"(fq));
        const int lane = fr | (fq << 4);
        const int src_up = (lane & 48) | ((fr + 15) & 15), src_dn = (lane & 48) | ((fr + 1) & 15);
        const int cv0 = u.pn * 128 + wc * 32 + 8 * fq;
#pragma unroll
        for (int n = 0; n < 2; ++n) {
            const int sv = cv0 + 4 * n, sg = FF + cv0 + 4 * n;
            const f32x4 vp = *(const f32x4*)(cw + sv), vm = *(const f32x4*)(cw + NUP + sv), vn = *(const f32x4*)(cw + 2 * NUP + sv), vb = *(const f32x4*)(cb + sv);
            const f32x4 gp = *(const f32x4*)(cw + sg), gm = *(const f32x4*)(cw + NUP + sg), gn = *(const f32x4*)(cw + 2 * NUP + sg), gb = *(const f32x4*)(cb + sg);
#pragma unroll
            for (int ai = 0; ai < 2; ++ai) {
                const int tok0 = u.pm * 248 + (2 * ai + wr) * 62 - 1;
#pragma unroll
                for (int m = 0; m < 4; ++m) { f32x4 zv, zg;
                    CONV_ONE(acc, ai, 0, n, m, zv, vp, vm, vn); CONV_ONE(acc, ai, 1, n, m, zg, gp, gm, gn);
                    zv = zv + vb; zg = zg + gb;
                    float ov[4];
#pragma unroll
                    for (int e = 0; e < 4; ++e) { const float x = zg[e]; const float uu = 1.5957691216f * (x + 0.044715f * x * x * x);
                        ov[e] = zv[e] * x * __builtin_amdgcn_rcpf(1.f + __expf(-uu)); }
                    if (ROW_VALID(m)) { const int t = tok0 + 16 * m + fr; u32x2 w; w.x = cvtpk(ov[0], ov[1]); w.y = cvtpk(ov[2], ov[3]);
                        *(u32x2*)(ACT + (size_t)t * FF + cv0 + 4 * n) = w; }
                    __builtin_amdgcn_sched_barrier(0); }
            }
        }
    }
};

struct EpiQkv {
    const float* ropec; const float* ropes; bf16_t* Q;
    DI void operator()(const f32x4 (&acc)[2][2][4][2], const Unit& u, int wr, int wc, int fr_, int fq_) const {
        int fr = fr_, fq = fq_; asm volatile("" : "+v"(fr), "+v"(fq));
        const int which = u.pn >> 2;
        bf16_t* base = Q + (size_t)which * ((size_t)T * 1024);
        const int i0 = 16 * (wc & 1) + 4 * fq;
#pragma unroll
        for (int ai = 0; ai < 2; ++ai)
#pragma unroll
            for (int m = 0; m < 4; ++m) { const int t = u.pm * BM + ai * HALF + wr * 64 + m * 16 + fr;
                f32x4 c4 = (f32x4){1.f, 1.f, 1.f, 1.f}, s4 = (f32x4){0.f, 0.f, 0.f, 0.f};
                if (which < 2) { const int pos = seq_pos(t); c4 = *(const f32x4*)(ropec + pos * 32 + i0); s4 = *(const f32x4*)(ropes + pos * 32 + i0); }
#pragma unroll
                for (int bj = 0; bj < 2; ++bj) { const f32x4 x1 = acc[ai][bj][m][0], x2 = acc[ai][bj][m][1];
                    f32x4 y1 = x1, y2 = x2;
                    if (which < 2) { y1 = x1 * c4 - x2 * s4; y2 = x2 * c4 + x1 * s4; }
                    if (which == 0) { y1 = y1 * (0.125f * 1.4426950408889634f); y2 = y2 * (0.125f * 1.4426950408889634f); }
                    u32x4 w; w.x = cvtpk(y1[0], y1[1]); w.y = cvtpk(y1[2], y1[3]); w.z = cvtpk(y2[0], y2[1]); w.w = cvtpk(y2[2], y2[3]);
                    *(u32x4*)(base + (size_t)t * 1024 + (u.pn & 3) * BM + bj * HALF + wc * 32 + 8 * fq) = w; } }
    }
};
}

namespace att {
constexpr int NW = 8, QBLK = 32, KVBLK = 64, LDQ = 1024;
constexpr float SCALE = 0.125f, THR = 8.f;
constexpr int SHM_V = KVBLK * 128 * 2, SHM_K = KVBLK * 64 * 2;
#define KSWZ(row, colB) ((row) * 128 + ((colB) ^ ((((row) >> 1) & 7) << 4)))
#define SBAR() __builtin_amdgcn_sched_barrier(0)
DI int crow(int r, int hi) { return (r & 3) + 8 * (r >> 2) + 4 * hi; }
DI void partialSM(f32x16& p0, f32x16& p1, float& m_reg, f32x16& negm, float& alpha) {
    constexpr float THR2 = THR * 1.4426950408889634f;
    float pmax = p0[0];
#pragma unroll
    for (int r = 1; r < 16; ++r) pmax = fmaxf(pmax, p0[r]);
#pragma unroll
    for (int r = 0; r < 16; ++r) pmax = fmaxf(pmax, p1[r]);
    { auto rr = __builtin_amdgcn_permlane32_swap(__float_as_uint(pmax), __float_as_uint(pmax), false, false);
      pmax = fmaxf(__uint_as_float(rr[0]), __uint_as_float(rr[1])); }
    const bool first = m_reg < -1e29f;
    if (__builtin_expect(__all(!first && pmax <= THR2), 1)) { alpha = 1.f; }
    else {
        const float d = first ? pmax : fmaxf(pmax, 0.f);
        alpha = first ? 0.f : __builtin_amdgcn_exp2f(-d);
        m_reg = first ? pmax : m_reg + d;
#pragma unroll
        for (int r = 0; r < 16; ++r) { p0[r] -= d; p1[r] -= d; negm[r] = -m_reg; }
    }
#pragma unroll
    for (int r = 0; r < 16; ++r) p0[r] = __builtin_amdgcn_exp2f(p0[r]);
}
DI void finishSM(f32x16& p0, f32x16& p1, float alpha, float& l_reg, bf16x8& pa0, bf16x8& pa1, bf16x8& pa2, bf16x8& pa3) {
#pragma unroll
    for (int r = 0; r < 16; ++r) p1[r] = __builtin_amdgcn_exp2f(p1[r]);
    float ps = 0;
#pragma unroll
    for (int r = 0; r < 16; ++r) ps += p0[r];
#pragma unroll
    for (int r = 0; r < 16; ++r) ps += p1[r];
    { auto rr = __builtin_amdgcn_permlane32_swap(__float_as_uint(ps), __float_as_uint(ps), false, false);
      ps = __uint_as_float(rr[0]) + __uint_as_float(rr[1]); }
    l_reg = l_reg * alpha + ps;
#define PK4(P, BASE, OUT) do { unsigned a0 = cvtpk(P[BASE + 0], P[BASE + 1]), a1 = cvtpk(P[BASE + 2], P[BASE + 3]);   \
    unsigned b0 = cvtpk(P[BASE + 4], P[BASE + 5]), b1 = cvtpk(P[BASE + 6], P[BASE + 7]);                              \
    auto r0 = __builtin_amdgcn_permlane32_swap(a0, b0, false, false); auto r1 = __builtin_amdgcn_permlane32_swap(a1, b1, false, false); \
    u32x4 w = {r0[0], r1[0], r0[1], r1[1]}; OUT = __builtin_bit_cast(bf16x8, w); } while (0)
    PK4(p0, 0, pa0); PK4(p0, 8, pa1); PK4(p1, 0, pa2); PK4(p1, 8, pa3);
#undef PK4
}
DI void qkt(f32x16& p0, f32x16& p1, const char* Ks, const bf16x8* qr, const f32x16& negm, int r32, int hi) {
    { const bf16x8 b0 = *reinterpret_cast<const bf16x8*>(Ks + KSWZ(r32, hi * 16));
      const bf16x8 b1 = *reinterpret_cast<const bf16x8*>(Ks + KSWZ(32 + r32, hi * 16));
      p0 = __builtin_amdgcn_mfma_f32_32x32x16_bf16(b0, qr[0], negm, 0, 0, 0);
      p1 = __builtin_amdgcn_mfma_f32_32x32x16_bf16(b1, qr[0], negm, 0, 0, 0); }
#pragma unroll
    for (int d0 = 1; d0 < 4; ++d0) { const int cb = (d0 * 16 + hi * 8) * 2;
        const bf16x8 b0 = *reinterpret_cast<const bf16x8*>(Ks + KSWZ(r32, cb));
        const bf16x8 b1 = *reinterpret_cast<const bf16x8*>(Ks + KSWZ(32 + r32, cb));
        p0 = __builtin_amdgcn_mfma_f32_32x32x16_bf16(b0, qr[d0], p0, 0, 0, 0);
        p1 = __builtin_amdgcn_mfma_f32_32x32x16_bf16(b1, qr[d0], p1, 0, 0, 0); }
}
DI int v_st(int k, int c) { const int kk = (k & ~0xC) | ((k & 4) << 1) | ((k & 8) >> 1); return ((kk >> 3) * 4 + (c >> 5)) * 512 + ((kk & 7) * 32 + (c & 31)) * 2; }
DI int v_rd_base(int lane) { return ((lane & 3) << 3) | (((lane >> 2) & 3) << 6) | (((lane >> 4) & 1) << 5) | (((lane >> 5) & 1) << 8); }
constexpr int v_rd_off(int d0, int ks, int half) { return d0 * 512 + ks * 4096 + half * 2048; }
template <int OFF> DI s16x4 tr_read(int vb) { s16x4 r; asm volatile("ds_read_b64_tr_b16 %0, %1 offset:%2" : "=&v"(r) : "v"(vb), "i"(OFF) : "memory"); return r; }
template <int D0> DI void pv_one(f32x16& od, int vb, bf16x8 pa0, bf16x8 pa1, bf16x8 pa2, bf16x8 pa3) {
    const s16x4 l0 = tr_read<v_rd_off(D0, 0, 0)>(vb), h0 = tr_read<v_rd_off(D0, 0, 1)>(vb), l1 = tr_read<v_rd_off(D0, 1, 0)>(vb), h1 = tr_read<v_rd_off(D0, 1, 1)>(vb);
    const s16x4 l2 = tr_read<v_rd_off(D0, 2, 0)>(vb), h2 = tr_read<v_rd_off(D0, 2, 1)>(vb), l3 = tr_read<v_rd_off(D0, 3, 0)>(vb), h3 = tr_read<v_rd_off(D0, 3, 1)>(vb);
    asm volatile("s_waitcnt lgkmcnt(0)" ::: "memory"); SBAR();
#define PKV(L, H) (bf16x8){L[0], L[1], L[2], L[3], H[0], H[1], H[2], H[3]}
    od = __builtin_amdgcn_mfma_f32_32x32x16_bf16(pa0, PKV(l0, h0), od, 0, 0, 0);
    od = __builtin_amdgcn_mfma_f32_32x32x16_bf16(pa1, PKV(l1, h1), od, 0, 0, 0);
    od = __builtin_amdgcn_mfma_f32_32x32x16_bf16(pa2, PKV(l2, h2), od, 0, 0, 0);
    od = __builtin_amdgcn_mfma_f32_32x32x16_bf16(pa3, PKV(l3, h3), od, 0, 0, 0);
#undef PKV
}
DI void pv_d0(f32x16* o, int vb, bf16x8 pa0, bf16x8 pa1, bf16x8 pa2, bf16x8 pa3) {
    pv_one<0>(o[0], vb, pa0, pa1, pa2, pa3); pv_one<1>(o[1], vb, pa0, pa1, pa2, pa3); pv_one<2>(o[2], vb, pa0, pa1, pa2, pa3); pv_one<3>(o[3], vb, pa0, pa1, pa2, pa3);
}

DI void attn_pass(const bf16_t* __restrict__ Qb, const bf16_t* __restrict__ Kh, const bf16_t* __restrict__ Vh, int seq, char* lds, f32x16 (&o)[4], float& l_out) {
    int tid_ = threadIdx.x; asm volatile("" : "+v"(tid_));
    const int tid = tid_, wid = tid >> 6, lane = tid & 63, r32 = lane & 31, hi = lane >> 5;
    char* V_lds = lds; char* K_lds = lds + 2 * SHM_V;
    float* ws = (float*)(lds + 2 * SHM_V + 2 * SHM_K) + wid * 64; float* al_l = ws + 32;
    float m_reg = -1e30f, l_reg = 0; bf16x8 qr[4]; f32x16 negm;
#pragma unroll
    for (int r = 0; r < 16; ++r) negm[r] = 0.f;
#pragma unroll
    for (int d = 0; d < 4; ++d)
#pragma unroll
        for (int r = 0; r < 16; ++r) o[d][r] = 0.f;
    const bf16_t* Qw = Qb + (size_t)(wid * QBLK + r32) * LDQ + hi * 8;
#pragma unroll
    for (int d0 = 0; d0 < 4; ++d0) qr[d0] = *reinterpret_cast<const bf16x8*>(Qw + d0 * 16);
    const int sr = tid >> 4, sc = (tid & 15) * 8, vst0 = v_st(sr, sc), vst1 = v_st(32 + sr, sc);
    const int kr = tid >> 3, kc = (tid & 7) * 8, kst = KSWZ(kr, kc * 2);
    const int vb0 = (int)(uintptr_t)V_lds + v_rd_base(lane);
    bf16x8 vsA0, vsA1, ksA, vsB0, vsB1, ksB;
#define SLOADA(k0) do { vsA0 = *reinterpret_cast<const bf16x8*>(&Vh[(size_t)((k0) + sr) * LDQ + sc]); vsA1 = *reinterpret_cast<const bf16x8*>(&Vh[(size_t)((k0) + 32 + sr) * LDQ + sc]); \
    ksA = *reinterpret_cast<const bf16x8*>(&Kh[(size_t)((k0) + kr) * LDQ + kc]); } while (0)
#define SLOADB(k0) do { vsB0 = *reinterpret_cast<const bf16x8*>(&Vh[(size_t)((k0) + sr) * LDQ + sc]); vsB1 = *reinterpret_cast<const bf16x8*>(&Vh[(size_t)((k0) + 32 + sr) * LDQ + sc]); \
    ksB = *reinterpret_cast<const bf16x8*>(&Kh[(size_t)((k0) + kr) * LDQ + kc]); } while (0)
#define SWRITEA(b) do { *(bf16x8*)(V_lds + (b) * SHM_V + vst0) = vsA0; *(bf16x8*)(V_lds + (b) * SHM_V + vst1) = vsA1; *(bf16x8*)(K_lds + (b) * SHM_K + kst) = ksA; } while (0)
#define SWRITEB(b) do { *(bf16x8*)(V_lds + (b) * SHM_V + vst0) = vsB0; *(bf16x8*)(V_lds + (b) * SHM_V + vst1) = vsB1; *(bf16x8*)(K_lds + (b) * SHM_K + kst) = ksB; } while (0)
#define SWAIT() asm volatile("s_waitcnt vmcnt(3)" ::: "memory")
#define RESC(a) do { if (__any((a) < 1.f)) { if (hi == 0) al_l[r32] = (a); asm volatile("s_waitcnt lgkmcnt(0)" ::: "memory"); \
    _Pragma("unroll") for (int d = 0; d < 4; ++d) _Pragma("unroll") for (int r = 0; r < 16; ++r) o[d][r] *= al_l[crow(r, hi)]; } } while (0)
    f32x16 pA0, pA1, pB0, pB1; float alA, alB; bf16x8 pa0, pa1, pa2, pa3; const int NT = seq / KVBLK;
    SLOADA(0); asm volatile("s_waitcnt vmcnt(0)" ::: "memory"); SWRITEA(0); __syncthreads();
    qkt(pA0, pA1, K_lds, qr, negm, r32, hi); partialSM(pA0, pA1, m_reg, negm, alA);
    SLOADB(KVBLK); if (2 < NT) SLOADA(2 * KVBLK);
    SWAIT(); SWRITEB(1); __syncthreads();
    for (int j = 1; j + 1 < NT; j += 2) {
        SBAR(); qkt(pB0, pB1, K_lds + SHM_K, qr, negm, r32, hi);
        finishSM(pA0, pA1, alA, l_reg, pa0, pa1, pa2, pa3); SBAR();
        SLOADB((j + 2) * KVBLK); SBAR();
        pv_d0(o, vb0, pa0, pa1, pa2, pa3); partialSM(pB0, pB1, m_reg, negm, alB);
        __syncthreads(); SWAIT(); SWRITEA(0);
        RESC(alB); __syncthreads();
        SBAR(); qkt(pA0, pA1, K_lds, qr, negm, r32, hi);
        finishSM(pB0, pB1, alB, l_reg, pa0, pa1, pa2, pa3); SBAR();
        if (j + 3 < NT) SLOADA((j + 3) * KVBLK); SBAR();
        pv_d0(o, vb0 + SHM_V, pa0, pa1, pa2, pa3); partialSM(pA0, pA1, m_reg, negm, alA);
        __syncthreads(); if (j + 3 < NT) SWAIT(); else asm volatile("s_waitcnt vmcnt(0)" ::: "memory"); SWRITEB(1);
        RESC(alA); __syncthreads();
    }
    SBAR(); qkt(pB0, pB1, K_lds + SHM_K, qr, negm, r32, hi);
    finishSM(pA0, pA1, alA, l_reg, pa0, pa1, pa2, pa3); SBAR();
    pv_d0(o, vb0, pa0, pa1, pa2, pa3); partialSM(pB0, pB1, m_reg, negm, alB);
    __syncthreads(); RESC(alB);
    finishSM(pB0, pB1, alB, l_reg, pa0, pa1, pa2, pa3); SBAR();
    pv_d0(o, vb0 + SHM_V, pa0, pa1, pa2, pa3);
    l_out = l_reg;
#undef SLOADA
#undef SLOADB
#undef SWRITEA
#undef SWRITEB
#undef SWAIT
#undef RESC
}
}

DI void tr_item(const float* W, int ldw, int K, bf16_t* WT, int n0, int k0, int srccol, int lane, LAS float* scr) {
#pragma unroll 8
    for (int i = 0; i < 32; ++i) { const int kk = 2 * i + (lane >> 5); scr[kk * 33 + (lane & 31)] = srccol >= 0 ? W[(size_t)(k0 + kk) * ldw + srccol] : 0.f; }
    asm volatile("s_waitcnt lgkmcnt(0)" ::: "memory");
    const int c = lane & 7;
#pragma unroll
    for (int j = 0; j < 4; ++j) { const int n = (lane >> 3) + 8 * j; const LAS float* s = scr + (8 * c) * 33 + n;
        u32x4 o; o.x = cvtpk(s[0 * 33], s[1 * 33]); o.y = cvtpk(s[2 * 33], s[3 * 33]); o.z = cvtpk(s[4 * 33], s[5 * 33]); o.w = cvtpk(s[6 * 33], s[7 * 33]);
        *(u32x4*)(WT + (size_t)(n0 + n) * K + k0 + 8 * c) = o; }
    asm volatile("s_waitcnt lgkmcnt(0)" ::: "memory");
}

DI void row_item(const float* xrow, const bf16_t* hrow, const float* gpost, float* orow, const float* gpre, bf16_t* hnrow, int lane) {
    f32x4 v[4];
#pragma unroll
    for (int j = 0; j < 4; ++j) v[j] = *((const f32x4*)xrow + lane + 64 * j);
    if (hrow) {
        f32x4 h[4]; float s = 0.f;
#pragma unroll
        for (int j = 0; j < 4; ++j) { const u32x2 w = *((const u32x2*)hrow + lane + 64 * j); h[j] = (f32x4){bflo(w.x), bfhi(w.x), bflo(w.y), bfhi(w.y)};
            s += (h[j].x * h[j].x + h[j].y * h[j].y) + (h[j].z * h[j].z + h[j].w * h[j].w); }
        const float rs = rsqrtf(wave_sum(s) * (1.f / DM) + 1e-6f);
#pragma unroll
        for (int j = 0; j < 4; ++j) { const f32x4 g = *((const f32x4*)gpost + lane + 64 * j); v[j] = v[j] + h[j] * rs * g; *((f32x4*)orow + lane + 64 * j) = v[j]; }
    }
    if (gpre) {
        float s = 0.f;
#pragma unroll
        for (int j = 0; j < 4; ++j) s += (v[j].x * v[j].x + v[j].y * v[j].y) + (v[j].z * v[j].z + v[j].w * v[j].w);
        const float rs = rsqrtf(wave_sum(s) * (1.f / DM) + 1e-6f);
#pragma unroll
        for (int j = 0; j < 4; ++j) { const f32x4 g = *((const f32x4*)gpre + lane + 64 * j); const f32x4 y = v[j] * rs * g;
            u32x2 w; w.x = cvtpk(y.x, y.y); w.y = cvtpk(y.z, y.w); *((u32x2*)hnrow + lane + 64 * j) = w; }
    }
}

DI void row_item2(const float* xa, const float* xb, const bf16_t* ha, const bf16_t* hb, const float* gpost, float* oa, float* ob, const float* gpre, bf16_t* hna, bf16_t* hnb, int lane) {
    f32x4 va[4], vb[4]; u32x2 wa[4], wb[4];
#pragma unroll
    for (int j = 0; j < 4; ++j) { va[j] = *((const f32x4*)xa + lane + 64 * j); vb[j] = *((const f32x4*)xb + lane + 64 * j); }
    if (ha) {
#pragma unroll
        for (int j = 0; j < 4; ++j) { wa[j] = *((const u32x2*)ha + lane + 64 * j); wb[j] = *((const u32x2*)hb + lane + 64 * j); }
        f32x4 h[4]; float s = 0.f;
#pragma unroll
        for (int j = 0; j < 4; ++j) { const u32x2 w = wa[j]; h[j] = (f32x4){bflo(w.x), bfhi(w.x), bflo(w.y), bfhi(w.y)}; s += (h[j].x * h[j].x + h[j].y * h[j].y) + (h[j].z * h[j].z + h[j].w * h[j].w); }
        float rs = rsqrtf(wave_sum(s) * (1.f / DM) + 1e-6f);
#pragma unroll
        for (int j = 0; j < 4; ++j) { const f32x4 g = *((const f32x4*)gpost + lane + 64 * j); va[j] = va[j] + h[j] * rs * g; *((f32x4*)oa + lane + 64 * j) = va[j]; }
        s = 0.f;
#pragma unroll
        for (int j = 0; j < 4; ++j) { const u32x2 w = wb[j]; h[j] = (f32x4){bflo(w.x), bfhi(w.x), bflo(w.y), bfhi(w.y)}; s += (h[j].x * h[j].x + h[j].y * h[j].y) + (h[j].z * h[j].z + h[j].w * h[j].w); }
        rs = rsqrtf(wave_sum(s) * (1.f / DM) + 1e-6f);
#pragma unroll
        for (int j = 0; j < 4; ++j) { const f32x4 g = *((const f32x4*)gpost + lane + 64 * j); vb[j] = vb[j] + h[j] * rs * g; *((f32x4*)ob + lane + 64 * j) = vb[j]; }
    }
    if (gpre) {
        float s = 0.f, t = 0.f;
#pragma unroll
        for (int j = 0; j < 4; ++j) { s += (va[j].x * va[j].x + va[j].y * va[j].y) + (va[j].z * va[j].z + va[j].w * va[j].w); t += (vb[j].x * vb[j].x + vb[j].y * vb[j].y) + (vb[j].z * vb[j].z + vb[j].w * vb[j].w); }
        const float rsa = rsqrtf(wave_sum(s) * (1.f / DM) + 1e-6f), rsb = rsqrtf(wave_sum(t) * (1.f / DM) + 1e-6f);
#pragma unroll
        for (int j = 0; j < 4; ++j) { const f32x4 g = *((const f32x4*)gpre + lane + 64 * j); const f32x4 ya = va[j] * rsa * g, yb = vb[j] * rsb * g;
            u32x2 w; w.x = cvtpk(ya.x, ya.y); w.y = cvtpk(ya.z, ya.w); *((u32x2*)hna + lane + 64 * j) = w;
            u32x2 w2; w2.x = cvtpk(yb.x, yb.y); w2.y = cvtpk(yb.z, yb.w); *((u32x2*)hnb + lane + 64 * j) = w2; }
    }
}

typedef const __attribute__((address_space(4))) Args* ArgsP;
DI ArgsP getargs() { unsigned long long kp = (unsigned long long)__builtin_amdgcn_kernarg_segment_ptr(); asm volatile("" : "+s"(kp)); return (ArgsP)kp; }
#define WSB (getargs()->ws)
#define DOB ((unsigned char*)getargs()->out)
#define x_prompt (getargs()->in[0])
#define x_sample (getargs()->in[1])
#define W_IN ((bf16_t*)(WSB + WS_WIN))
#define W_G ((bf16_t*)(WSB + WS_WG))
#define W_OUT0 ((bf16_t*)(WSB + WS_WOUT0))
#define W_UP ((bf16_t*)(WSB + WS_WUP))
#define W_DN ((bf16_t*)(WSB + WS_WDN))
#define W_QKV ((bf16_t*)(WSB + WS_WQKV))
#define W_O ((bf16_t*)(WSB + WS_WO))
#define ROPEC ((float*)(WSB + WS_ROPE))
#define ROPES (ROPEC + TPR * 32)
#define BONUS ((float*)(WSB + WS_BONUS))
#define DFTM ((bf16_t*)(WSB + WS_DFT))
#define HN ((bf16_t*)(WSB + WS_HN))
#define RKV ((bf16_t*)(WSB + WS_RKV))
#define LDB ((bf16_t*)(WSB + WS_LD))
#define GATE ((bf16_t*)(WSB + WS_GATE))
#define YC ((bf16_t*)(WSB + WS_YC))
#define RAWB ((bf16_t*)(WSB + WS_RAWB))
#define ACT ((bf16_t*)(WSB + WS_ACT))
#define QB ((bf16_t*)(WSB + WS_Q))
#define KB ((bf16_t*)(WSB + WS_K))
#define VB ((bf16_t*)(WSB + WS_V))
#define UTS ((bf16_t*)(DOB + DO_UTS))
#define UTP ((bf16_t*)(DOB + DO_UTP))
#define YF ((bf16_t*)(DOB + DO_YF))
#define YB ((bf16_t*)(DOB + DO_YB))
#define YCS ((bf16_t*)(WSB + 448 * MiB))
#define SSB ((bf16_t*)(DOB + DO_SS))

template <bool WITH_P, bool FROM_STATE, bool WITH_Y, bool STORE_E>
DI void scan_unit(LAS unsigned char* lds, const int sq, const int h, const int d, const int seg, const int nseg) {
    int tid_l = threadIdx.x; asm volatile("" : "+v"(tid_l)); const int tid = tid_l, lane = tid & 63, wave = __builtin_amdgcn_readfirstlane(tid >> 6);
    const int s0 = sq == 0 ? 0 : TPR + (sq - 1) * SL, len = sq == 0 ? TPR : SL, seglen = len / nseg, p0 = seg * seglen;
    const int u = sq * 16 + h * 2 + d;
    float* EST = (float*)(DOB + 96 * MiB); float* PST = (float*)(DOB + 128 * MiB);
    LAS float* Aa = (LAS float*)lds; LAS float* Bb = Aa + 4096; LAS float* Kd = Bb + 4096; LAS float* Rr = Kd + 4096; LAS float* Vv = Rr + 4096; LAS float* Wd = Vv + 4096;
    LAS float* WL = Wd + 4096; LAS float* AL = WL + 4096; LAS float* Yb = AL + 4096; LAS float* Sx = Yb; LAS float* We = Yb + 4096;
    const float* w0 = getargs()->in[7] + d * 512 + h * 64; const float* w2 = getargs()->in[8] + (size_t)d * 64 * 512 + h * 64;
    const float* a0 = getargs()->in[9] + d * 512 + h * 64; const float* a2 = getargs()->in[10] + (size_t)d * 64 * 512 + h * 64;
    const float* kkp = getargs()->in[12] + h * 64; const float* kap = getargs()->in[13] + h * 64; const float* rkp = getargs()->in[14] + h * 64;
    bf16_t* YD = d ? YB : YF; float* BON = BONUS + (size_t)d * T * 8;
    const int mt0 = 2 * (wave & 1), ntile = wave >> 1;
    bf16x8 bw[2], ba[2];
#pragma unroll
    for (int ks = 0; ks < 2; ++ks) { float fw[8], fa[8];
#pragma unroll
        for (int j = 0; j < 8; ++j) { const int k = ks * 32 + (lane >> 4) * 8 + j; fw[j] = w2[(size_t)k * 512 + ntile * 16 + (lane & 15)]; fa[j] = a2[(size_t)k * 512 + ntile * 16 + (lane & 15)]; }
        u32x4 pw = {cvtpk(fw[0], fw[1]), cvtpk(fw[2], fw[3]), cvtpk(fw[4], fw[5]), cvtpk(fw[6], fw[7])}; bw[ks] = __builtin_bit_cast(bf16x8, pw);
        u32x4 pa = {cvtpk(fa[0], fa[1]), cvtpk(fa[2], fa[3]), cvtpk(fa[4], fa[5]), cvtpk(fa[6], fa[7])}; ba[ks] = __builtin_bit_cast(bf16x8, pa); }
    const int pi = tid >> 3, pc = (tid & 7) * 8;
    f32x4 w0v[2], a0v[2], kkv[2], kav[2], rkv[2];
#pragma unroll
    for (int hh = 0; hh < 2; ++hh) { w0v[hh] = *(const f32x4*)(w0 + pc + 4 * hh); a0v[hh] = *(const f32x4*)(a0 + pc + 4 * hh); kkv[hh] = *(const f32x4*)(kkp + pc + 4 * hh);
        kav[hh] = *(const f32x4*)(kap + pc + 4 * hh); rkv[hh] = *(const f32x4*)(rkp + pc + 4 * hh); }
    const int rl = lane >> 3, cgp = lane & 7, row = 8 * wave + rl;
    float st[8], sp[8];
#pragma unroll
    for (int j = 0; j < 8; ++j) { st[j] = 0.f; sp[j] = (8 * cgp + j == row) ? 1.f : 0.f; }
    if (FROM_STATE) {
        const float* e0 = EST + ((size_t)(u * 8 + 0) * 64 + row) * 64 + 8 * cgp;
#pragma unroll
        for (int j = 0; j < 8; ++j) st[j] = e0[j];
        for (int i = 1; i < seg; ++i) {
#pragma unroll
            for (int j = 0; j < 8; ++j) Sx[row * 64 + 8 * cgp + j] = st[j];
            __syncthreads();
            const float* ei = EST + ((size_t)(u * 8 + i) * 64 + row) * 64 + 8 * cgp; const float* pp = PST + (size_t)(u * 8 + i) * 4096 + 8 * cgp;
            float ac[8];
#pragma unroll
            for (int j = 0; j < 8; ++j) ac[j] = ei[j];
            for (int k = 0; k < 64; ++k) { const float sk = Sx[row * 64 + k]; const f32x4 q0 = *(const f32x4*)(pp + k * 64), q1 = *(const f32x4*)(pp + k * 64 + 4);
#pragma unroll
                for (int j = 0; j < 4; ++j) { ac[j] += sk * q0[j]; ac[4 + j] += sk * q1[j]; } }
#pragma unroll
            for (int j = 0; j < 8; ++j) st[j] = ac[j];
            __syncthreads();
        }
    }
    f32x2 st2[4], sp2[4];
#pragma unroll
    for (int j = 0; j < 4; ++j) { st2[j] = (f32x2){st[2 * j], st[2 * j + 1]}; sp2[j] = (f32x2){sp[2 * j], sp[2 * j + 1]}; }
    const int nch = seglen / 64;
    u32x4 pr, pk_, pv; bf16x8 fa_w[2][2], fa_a[2][2];
#define SCAN_TOK(c, i) (d ? (s0 + len - 1 - (p0 + (c) * 64 + (i))) : (s0 + p0 + (c) * 64 + (i)))
#define SCAN_LOAD(c) do { const int t_ = SCAN_TOK(c, pi); const bf16_t* rp = RKV + (size_t)t_ * 1536 + h * 64 + pc; \
    pr = *(const u32x4*)rp; pk_ = *(const u32x4*)(rp + 512); pv = *(const u32x4*)(rp + 1024); \
    _Pragma("unroll") for (int mm = 0; mm < 2; ++mm) { const int ta_ = SCAN_TOK(c, (mt0 + mm) * 16 + (lane & 15)); const bf16_t* lp = LDB + (size_t)ta_ * 384 + d * 64 + (lane >> 4) * 8; \
        fa_w[mm][0] = *(const bf16x8*)lp; fa_w[mm][1] = *(const bf16x8*)(lp + 32); fa_a[mm][0] = *(const bf16x8*)(lp + 128); fa_a[mm][1] = *(const bf16x8*)(lp + 160); } } while (0)
    SCAN_LOAD(0);
    for (int c = 0; c < nch; ++c) {
#pragma unroll
        for (int mm = 0; mm < 2; ++mm) { f32x4 cw_ = {0.f, 0.f, 0.f, 0.f}, ca_ = {0.f, 0.f, 0.f, 0.f};
          cw_ = __builtin_amdgcn_mfma_f32_16x16x32_bf16(fa_w[mm][0], bw[0], cw_, 0, 0, 0); cw_ = __builtin_amdgcn_mfma_f32_16x16x32_bf16(fa_w[mm][1], bw[1], cw_, 0, 0, 0);
          ca_ = __builtin_amdgcn_mfma_f32_16x16x32_bf16(fa_a[mm][0], ba[0], ca_, 0, 0, 0); ca_ = __builtin_amdgcn_mfma_f32_16x16x32_bf16(fa_a[mm][1], ba[1], ca_, 0, 0, 0);
#pragma unroll
          for (int j = 0; j < 4; ++j) { const int rr = (mt0 + mm) * 16 + (lane >> 4) * 4 + j, cc = ntile * 16 + (lane & 15); WL[rr * 64 + cc] = cw_[j]; AL[rr * 64 + cc] = ca_[j]; } }
        __syncthreads();
        f32x4 r4[2], v4[2], kd4[2], a4[2], b4[2];
        { const unsigned prw[4] = {pr.x, pr.y, pr.z, pr.w}, pkw[4] = {pk_.x, pk_.y, pk_.z, pk_.w}, pvw[4] = {pv.x, pv.y, pv.z, pv.w};
          f32x4 ic[2], kk4[2]; float ss = 0.f, bp = 0.f;
#pragma unroll
          for (int hh = 0; hh < 2; ++hh) { const f32x4 wl = *(const LAS f32x4*)(WL + pi * 64 + pc + 4 * hh), al = *(const LAS f32x4*)(AL + pi * 64 + pc + 4 * hh);
              r4[hh] = (f32x4){bflo(prw[2 * hh]), bfhi(prw[2 * hh]), bflo(prw[2 * hh + 1]), bfhi(prw[2 * hh + 1])};
              const f32x4 k4 = {bflo(pkw[2 * hh]), bfhi(pkw[2 * hh]), bflo(pkw[2 * hh + 1]), bfhi(pkw[2 * hh + 1])};
              v4[hh] = (f32x4){bflo(pvw[2 * hh]), bfhi(pvw[2 * hh]), bflo(pvw[2 * hh + 1]), bfhi(pvw[2 * hh + 1])};
              f32x4 lw;
#pragma unroll
              for (int e = 0; e < 4; ++e) { const float sg = sigmoidf_(w0v[hh][e] + wl[e]); lw[e] = -0.6065306597126334f * sg; ic[hh][e] = sigmoidf_(a0v[hh][e] + al[e]);
                  kk4[hh][e] = k4[e] * kkv[hh][e]; ss += kk4[hh][e] * kk4[hh][e]; kd4[hh][e] = k4[e] * (1.f + (ic[hh][e] - 1.f) * kav[hh][e]); bp += r4[hh][e] * kd4[hh][e] * rkv[hh][e]; }
              *(LAS f32x4*)(Wd + pi * 64 + pc + 4 * hh) = lw; }
          ss = red8(ss); bp = red8(bp);
          const float inv = 1.f / fmaxf(sqrtf(ss), 1e-12f);
#pragma unroll
          for (int hh = 0; hh < 2; ++hh)
#pragma unroll
              for (int e = 0; e < 4; ++e) { const float kn = kk4[hh][e] * inv; a4[hh][e] = -kn; b4[hh][e] = kn * ic[hh][e]; }
          if ((tid & 7) == 0) BON[(size_t)SCAN_TOK(c, pi) * 8 + h] = bp; }
        __syncthreads();
        if (tid < 64) { float vals[64];
#pragma unroll
            for (int t = 0; t < 64; ++t) vals[t] = Wd[t * 64 + tid];
            float acc_ = 0.f;
#pragma unroll
            for (int t = 0; t < 64; ++t) { acc_ += vals[t]; Wd[t * 64 + tid] = acc_; } }
        __syncthreads();
#pragma unroll
        for (int hh = 0; hh < 2; ++hh) { const f32x4 Lt = *(const LAS f32x4*)(Wd + pi * 64 + pc + 4 * hh); f32x4 Lp = {0.f, 0.f, 0.f, 0.f}; if (pi > 0) Lp = *(const LAS f32x4*)(Wd + (pi - 1) * 64 + pc + 4 * hh);
          f32x4 at, bt, kt, rt, et;
#pragma unroll
          for (int e = 0; e < 4; ++e) { const float ep = __expf(Lp[e]); et[e] = __expf(Lt[e]); const float eti = __builtin_amdgcn_rcpf(et[e]);
              at[e] = a4[hh][e] * ep; bt[e] = b4[hh][e] * eti; kt[e] = kd4[hh][e] * eti; rt[e] = r4[hh][e] * et[e]; }
          *(LAS f32x4*)(Aa + pi * 64 + pc + 4 * hh) = at; *(LAS f32x4*)(Bb + pi * 64 + pc + 4 * hh) = bt;
          *(LAS f32x4*)(Kd + pi * 64 + pc + 4 * hh) = kt; *(LAS f32x4*)(Rr + pi * 64 + pc + 4 * hh) = rt; *(LAS f32x4*)(Vv + pi * 64 + pc + 4 * hh) = v4[hh];
          if (pi == 63) *(LAS f32x4*)(We + pc + 4 * hh) = et; }
        __syncthreads();
        if (c + 1 < nch) SCAN_LOAD(c + 1);
        float ykq = 0.f;
#pragma unroll 1
        for (int q = 0; q < 32; ++q) {
#pragma unroll
        for (int ii = 0; ii < 2; ++ii) { const int i = 2 * q + ii;
            const f32x4 a_0 = *(const LAS f32x4*)(Aa + i * 64 + 8 * cgp), a_1 = *(const LAS f32x4*)(Aa + i * 64 + 8 * cgp + 4);
            const f32x4 b_0 = *(const LAS f32x4*)(Bb + i * 64 + 8 * cgp), b_1 = *(const LAS f32x4*)(Bb + i * 64 + 8 * cgp + 4);
            const f32x4 k_0 = *(const LAS f32x4*)(Kd + i * 64 + 8 * cgp), k_1 = *(const LAS f32x4*)(Kd + i * 64 + 8 * cgp + 4);
            const f32x4 r_0 = *(const LAS f32x4*)(Rr + i * 64 + 8 * cgp), r_1 = *(const LAS f32x4*)(Rr + i * 64 + 8 * cgp + 4);
            const float vv = Vv[i * 64 + row];
#define LO2(v) __builtin_shufflevector(v, v, 0, 1)
#define HI2(v) __builtin_shufflevector(v, v, 2, 3)
            const f32x2 a2_[4] = {LO2(a_0), HI2(a_0), LO2(a_1), HI2(a_1)}, b2_[4] = {LO2(b_0), HI2(b_0), LO2(b_1), HI2(b_1)};
            const f32x2 k2_[4] = {LO2(k_0), HI2(k_0), LO2(k_1), HI2(k_1)}, r2_[4] = {LO2(r_0), HI2(r_0), LO2(r_1), HI2(r_1)};
            f32x2 sa2 = st2[0] * a2_[0]; sa2 = st2[1] * a2_[1] + sa2; sa2 = st2[2] * a2_[2] + sa2; sa2 = st2[3] * a2_[3] + sa2;
            const float sa = red8(sa2.x + sa2.y);
            const f32x2 sab = {sa, sa}, vvb = {vv, vv};
#pragma unroll
            for (int j = 0; j < 4; ++j) { st2[j] = vvb * k2_[j] + st2[j]; st2[j] = sab * b2_[j] + st2[j]; }
            if (WITH_P) {
                f32x2 pa2 = sp2[0] * a2_[0]; pa2 = sp2[1] * a2_[1] + pa2; pa2 = sp2[2] * a2_[2] + pa2; pa2 = sp2[3] * a2_[3] + pa2;
                const float pa = red8(pa2.x + pa2.y); const f32x2 pab = {pa, pa};
#pragma unroll
                for (int j = 0; j < 4; ++j) sp2[j] = pab * b2_[j] + sp2[j];
            }
            if (WITH_Y) {
            f32x2 y2 = st2[0] * r2_[0]; y2 = st2[1] * r2_[1] + y2; y2 = st2[2] * r2_[2] + y2; y2 = st2[3] * r2_[3] + y2;
            const float y = red8(y2.x + y2.y);
            if (cgp == (i & 7)) ykq = y; }
        }
        if (WITH_Y) { if ((q & 3) == 3) Yb[(8 * (q >> 2) + cgp) * 64 + row] = ykq; } }
        { const f32x4 we0 = *(const LAS f32x4*)(We + 8 * cgp), we1 = *(const LAS f32x4*)(We + 8 * cgp + 4);
          const f32x2 we2[4] = {LO2(we0), HI2(we0), LO2(we1), HI2(we1)};
#pragma unroll
          for (int j = 0; j < 4; ++j) { st2[j] = st2[j] * we2[j]; if (WITH_P) sp2[j] = sp2[j] * we2[j]; } }
        if (WITH_Y) {
            __syncthreads();
            { const f32x4 y0 = *(const LAS f32x4*)(Yb + pi * 64 + pc), y1 = *(const LAS f32x4*)(Yb + pi * 64 + pc + 4);
              u32x4 w; w.x = cvtpk(y0[0], y0[1]); w.y = cvtpk(y0[2], y0[3]); w.z = cvtpk(y1[0], y1[1]); w.w = cvtpk(y1[2], y1[3]);
              *(u32x4*)(YD + (size_t)SCAN_TOK(c, pi) * 512 + h * 64 + pc) = w; }
        }
    }
#undef SCAN_TOK
#undef SCAN_LOAD
    if (STORE_E) {
        float* eo = EST + ((size_t)(u * 8 + seg) * 64 + row) * 64 + 8 * cgp;
        *(f32x4*)eo = (f32x4){st2[0].x, st2[0].y, st2[1].x, st2[1].y}; *(f32x4*)(eo + 4) = (f32x4){st2[2].x, st2[2].y, st2[3].x, st2[3].y};
    }
    if (WITH_P) {
        float* po = PST + ((size_t)(u * 8 + seg) * 64 + row) * 64 + 8 * cgp;
        *(f32x4*)po = (f32x4){sp2[0].x, sp2[0].y, sp2[1].x, sp2[1].y}; *(f32x4*)(po + 4) = (f32x4){sp2[2].x, sp2[2].y, sp2[3].x, sp2[3].y};
    }
}

#define XB_TMO      128
#define XB_XCNT(j)  (256  + 64 * (j))
#define XB_XSUB(j)  (1280 + 64 * (j))
#define XB_XGEN(j)  (2304 + 64 * (j))
#define XB_TOP      3328
#define XB_TOPGEN   3392
#define XCD_BAR_WORDS 3456
#define XB_SPIN_CAP (1u << 23)
DI unsigned xb_ld(unsigned* p)              { return __hip_atomic_load(p, __ATOMIC_RELAXED, __HIP_MEMORY_SCOPE_AGENT); }
DI unsigned xb_add(unsigned* p, unsigned v) { return __hip_atomic_fetch_add(p, v, __ATOMIC_RELAXED, __HIP_MEMORY_SCOPE_AGENT); }
DI unsigned xb_xcc_id() { return (unsigned)__builtin_amdgcn_s_getreg((3 << 11) | 20) & 0xFu; }
#define XB_SPIN(cond, bar) do { unsigned _sp = 0; while (cond) { __builtin_amdgcn_s_sleep(1); \
    if ((++_sp & 255u) == 0u) { if (xb_ld(&(bar)[XB_TMO])) break; if (_sp > XB_SPIN_CAP) { atomicAdd(&(bar)[XB_TMO], 1u); break; } } } } while (0)
DI void xcd_barrier_complete(unsigned* bar, unsigned x, unsigned& nloc, unsigned& nx) {
    const unsigned G = gridDim.x;
    unsigned sum, cnt, mine, sp = 0u;
    for (;;) {
        sum = 0u; cnt = 0u; mine = 0u;
#pragma unroll
        for (unsigned j = 0; j < 16; ++j) { const unsigned c = xb_ld(&bar[XB_XCNT(j)]); sum += c; cnt += (c > 0u) ? 1u : 0u; mine = (j == x) ? c : mine; }
        if (sum == G) break;
        __builtin_amdgcn_s_sleep(1);
        if ((++sp & 255u) == 0u) { if (xb_ld(&bar[XB_TMO])) break; if (sp > XB_SPIN_CAP) { atomicAdd(&bar[XB_TMO], 1u); break; } }
    }
    nloc = mine > 0u ? mine : 1u; nx = cnt > 0u ? cnt : 1u;
}
DI void xcd_barrier(unsigned* bar, const unsigned x, volatile LAS unsigned* st) {
    asm volatile("s_waitcnt vmcnt(0)" ::: "memory");
    __syncthreads();
    if (threadIdx.x == 0) {
        __builtin_amdgcn_s_waitcnt(0);
        unsigned nloc = st[0], nx = st[1];
        if (nloc == 0u) { xcd_barrier_complete(bar, x, nloc, nx); st[0] = nloc; st[1] = nx; }
        const unsigned old = xb_add(&bar[XB_XSUB(x)], 1u);
        const unsigned gen = old / nloc;
        if (old + 1u == (gen + 1u) * nloc) {
            __builtin_amdgcn_fence(__ATOMIC_RELEASE, "agent");
            asm volatile("s_waitcnt vmcnt(0)" ::: "memory");
            const unsigned og = xb_add(&bar[XB_TOP], 1u);
            const unsigned tg = og / nx;
            if (og + 1u == (tg + 1u) * nx) xb_add(&bar[XB_TOPGEN], 1u);
            else XB_SPIN(xb_ld(&bar[XB_TOPGEN]) == tg, bar);
            __builtin_amdgcn_fence(__ATOMIC_ACQUIRE, "agent");
            xb_add(&bar[XB_XGEN(x)], 1u);
            asm volatile("s_waitcnt vmcnt(0)" ::: "memory");
        } else {
            XB_SPIN(xb_ld(&bar[XB_XGEN(x)]) == gen, bar);
            __builtin_amdgcn_fence(__ATOMIC_ACQUIRE, "agent");
            asm volatile("s_waitcnt vmcnt(0)" ::: "memory");
        }
    }
    __syncthreads();
}
#define GSYNC() xcd_barrier((unsigned*)(WSB + 4096), xb_xcc_id(), (volatile LAS unsigned*)(lds + LDS_BYTES - 64))
#define PHASE_IDS int tid_l = threadIdx.x; asm volatile("" : "+v"(tid_l)); const int tid = tid_l, lane = tid & 63, wave = __builtin_amdgcn_readfirstlane(tid >> 6), G = gridDim.x, bx = blockIdx.x, gw = bx * 8 + wave, NGW = G * 8, gtid = bx * 512 + tid, NTH = G * 512; (void)lane; (void)gw; (void)NGW; (void)gtid; (void)NTH; (void)wave
__global__ void __launch_bounds__(512, 2) fwd_mega(Args a_unused) {
    extern __shared__ __attribute__((aligned(16))) unsigned char lds_raw[];
    LAS unsigned char* lds = (LAS unsigned char*)lds_raw;
    cg::grid_group grid = cg::this_grid();
    if (threadIdx.x < 16) ((LAS unsigned*)(lds + LDS_BYTES - 64))[threadIdx.x] = 0u;
    __syncthreads();
    REP(0) if (PH(0)) { PHASE_IDS;
        LAS float* scr = (LAS float*)(lds + wave * 16384);
        constexpr int I0 = 16 * 64, I1 = 2 * 16, I2 = 16 * 32, I3 = 16 * 176, I4 = 44 * 32, I5 = 16 * 96, I6 = 16 * 32;
        constexpr int NITEMS = I0 + I1 + I2 + 2 * I3 + 2 * I4 + I5 + I6;
        for (int it = gw; it < NITEMS; it += NGW) {
            int r = it; const int ln = lane & 31;
            if (r < I0) { const int nblk = 64, kb = r / nblk, nb = r % nblk; const int n = 512 + nb * 32 + ln; const int src = n < MIXIN ? n : -1;
                tr_item(getargs()->in[4], MIXIN, 1024, W_IN, 512 + nb * 32, kb * 64, src, lane, scr); continue; } r -= I0;
            if (r < I1) { const int nblk = 16, kb = r / nblk, nb = r % nblk; tr_item(getargs()->in[11], 512, 128, W_G, nb * 32, kb * 64, nb * 32 + ln, lane, scr); continue; } r -= I1;
            if (r < I2) { const int nblk = 32, kb = r / nblk, nb = r % nblk; tr_item(getargs()->in[17], 1024, 1024, W_OUT0, nb * 32, kb * 64, nb * 32 + ln, lane, scr); continue; } r -= I2;
            if (r < 2 * I3) { const int l = r / I3; r -= l * I3; const int nblk = 176, kb = r / nblk, nb = r % nblk; const int n = nb * 32 + ln;
                const int src = (n >> 8) * 128 + (n & 127) + ((n >> 7) & 1) * FF;
                tr_item(getargs()->in[29] + (size_t)l * 1024 * NUP, NUP, 1024, W_UP + (size_t)l * NUP * 1024, nb * 32, kb * 64, src, lane, scr); continue; } r -= 2 * I3;
            if (r < 2 * I4) { const int l = r / I4; r -= l * I4; const int nblk = 32, kb = r / nblk, nb = r % nblk;
                tr_item(getargs()->in[32] + (size_t)l * FF * 1024, 1024, FF, W_DN + (size_t)l * 1024 * FF, nb * 32, kb * 64, nb * 32 + ln, lane, scr); continue; } r -= 2 * I4;
            if (r < I5) { const int nblk = 96, kb = r / nblk, nb = r % nblk; const int n = nb * 32 + ln; int src = n;
                if (n < 2048) { const int p = n & 63; src = (n & ~63) + 32 * ((p >> 2) & 1) + 4 * (p >> 3) + (p & 3); }
                tr_item(getargs()->in[20], 3072, 1024, W_QKV, nb * 32, kb * 64, src, lane, scr); continue; } r -= I5;
            { const int nblk = 32, kb = r / nblk, nb = r % nblk; tr_item(getargs()->in[26], 1024, 1024, W_O, nb * 32, kb * 64, nb * 32 + ln, lane, scr); }
        }
        for (int e = gtid; e < 512 * 1024; e += NTH) { const int k = e >> 9, n = e & 511, cs = n >> 8, g = (n >> 5) & 7, c2 = n & 31;
            const float* wr_ = getargs()->in[4] + (size_t)k * MIXIN + g * 64; float s = 0.f; const int cf = (cs && c2 == 0) ? 32 : c2; const bool use_sin = cs && c2 != 0;
            for (int c = 0; c < 64; ++c) { const float ph = (float)((c * cf) & 63) * (1.f / 64.f); s += wr_[c] * (use_sin ? __builtin_amdgcn_sinf(ph) : __builtin_amdgcn_cosf(ph)); }
            W_IN[(size_t)n * 1024 + k] = f2bf(s); }
        for (int e = gtid; e < 4608 * 512; e += NTH) { const int row = e >> 9, j0 = (e & 511) * 8; const int kp = row < 2304 ? row : row - 2304; float v[8];
#pragma unroll
            for (int jj = 0; jj < 8; ++jj) { const float ph = (float)((kp * (j0 + jj)) & 4095) * (1.f / 4096.f); v[jj] = row < 2304 ? __builtin_amdgcn_cosf(ph) : __builtin_amdgcn_sinf(ph); }
            u32x4 w; w.x = cvtpk(v[0], v[1]); w.y = cvtpk(v[2], v[3]); w.z = cvtpk(v[4], v[5]); w.w = cvtpk(v[6], v[7]);
            *(u32x4*)(DFTM + (size_t)row * 4096 + j0) = w; }
        for (int e = gtid; e < TPR * 32; e += NTH) { const int pos = e >> 5, i = e & 31; const float invf = exp2f(-(float)i * (13.287712379549449f / 32.f));
            double rev = (double)pos * (double)invf * 0.15915494309189535; rev -= floor(rev); const float fr_ = (float)rev;
            ROPEC[e] = __builtin_amdgcn_cosf(fr_); ROPES[e] = __builtin_amdgcn_sinf(fr_); }
        if (bx == 0) for (int w_ = tid; w_ < XCD_BAR_WORDS; w_ += 512) ((unsigned*)(WSB + 4096))[w_] = 0u;
        for (int m = gw; m < T; m += 2 * NGW) row_item2(xin_row(x_prompt, x_sample, m), xin_row(x_prompt, x_sample, m + NGW), nullptr, nullptr, nullptr, nullptr, nullptr, getargs()->in[2], HN + (size_t)m * DM, HN + (size_t)(m + NGW) * DM, lane);
    }
    grid.sync();
    if (threadIdx.x == 0) (void)xb_add(&((unsigned*)(WSB + 4096))[XB_XCNT(xb_xcc_id())], 1u);

#ifdef EXTRASYNC
    for (int es_ = 0; es_ < 20; ++es_) GSYNC();
#endif
    REP(1) if (PH(1)) { PHASE_IDS;
        pg8::Gemm g{HN - DM, W_IN, 1024, 1024, 1024};
        pg8::Sched S; S.init(199, 10, G, bx, (size_t)248 * 2048, (size_t)256 * 2048, 1 << 20, 0);
        pg8::EpiIn E{getargs()->in[5], getargs()->in[6], UTS, UTP, RKV, LDB};
        pg8::gemm_phase<pg8::EpiIn, 1>(lds, g, S, E);
    }
    GSYNC();

    REP(2) if (PH(2)) { PHASE_IDS;
#pragma unroll 1
        for (int gi = 0; gi < 2; ++gi) {
            const bf16_t* Ap = gi == 1 ? (const bf16_t*)(LDB + 256) : (const bf16_t*)DFTM;
            const bf16_t* Bp = gi == 0 ? (const bf16_t*)UTS : (const bf16_t*)W_G;
            const int Kk = gi == 1 ? 128 : 4096, lda = gi == 1 ? 384 : 4096, ldb = Kk;
            const int nM = gi == 1 ? 192 : 216, nN = 2, tpb = gi == 1 ? (1 << 20) : 18;
            const size_t bb = gi == 1 ? 0 : (size_t)512 * 4096 * 2;
            bf16_t* Op = gi == 0 ? YCS : GATE; const int ldc = 512;
            pg8::Gemm g{Ap, Bp, Kk, lda, ldb}; pg8::Sched S; S.init(nM, nN, G, bx, (size_t)256 * lda * 2, (size_t)256 * ldb * 2, tpb, bb);
            pg8::EpiStore E{Op, ldc, 0, 1.f}; pg8::gemm_phase<pg8::EpiStore, 0>(lds, g, S, E);
        }
    }
    GSYNC();

    REP(3) if (PH(3)) {
        if (blockIdx.x < 240) { int sq, h, d, seg, nseg; const int b_ = blockIdx.x;
            if (b_ < 112) { const int hd = b_ / 7; seg = b_ % 7; sq = 0; h = hd >> 1; d = hd & 1; nseg = 8; }
            else { const int v = b_ - 112; sq = 1 + (v >> 4); h = (v >> 1) & 7; d = v & 1; seg = 0; nseg = 2; }
            if (seg == 0) scan_unit<false, false, true, true>(lds, sq, h, d, seg, nseg); else scan_unit<true, false, false, true>(lds, sq, h, d, seg, nseg); }
        GSYNC();
        if (blockIdx.x < 240) { int sq, h, d, seg, nseg; const int b_ = blockIdx.x;
            if (b_ < 112) { const int hd = b_ / 7; seg = 1 + b_ % 7; sq = 0; h = hd >> 1; d = hd & 1; nseg = 8; }
            else { const int v = b_ - 112; sq = 1 + (v >> 4); h = (v >> 1) & 7; d = v & 1; seg = 1; nseg = 2; }
            scan_unit<false, true, true, false>(lds, sq, h, d, seg, nseg); }
    }
    GSYNC();

    if (PH(4)) { PHASE_IDS;
        { const int c = gtid & 511, g = c >> 6, cc = c & 63;
          const bool mtok = cc > 32; const int ch = mtok ? 64 - cc : cc;
          const float hs = ((ch != 0) && (ch != 32)) ? 1.f : 0.f;
          const int colU = (ch == 32) ? 256 + g * 32 : g * 32 + ch, colS = 256 + g * 32 + ch;
          for (int it0 = gtid; it0 < TPR * 512; it0 += 4 * NTH) {
              unsigned short vcu[4][4], vsu[4][4], vcs[4][4], vss[4][4]; float sKv[4]; int s2pv[4];
#pragma unroll
              for (int q = 0; q < 4; ++q) { const int sp = (it0 + q * NTH) >> 9; const int s2p = mtok ? ((TPR - sp) & (TPR - 1)) : sp; s2pv[q] = s2p;
                  const int k = s2p & 4095; const bool mir = k > 2048; const int kp = mir ? 4096 - k : k; sKv[q] = mir ? -1.f : 1.f;
#pragma unroll
                  for (int s2 = 0; s2 < 4; ++s2) { const bf16_t* bc = YCS + ((size_t)(s2 * 4608 + kp)) * 512; const bf16_t* bs = bc + (size_t)2304 * 512;
                      vcu[q][s2] = bc[colU]; vsu[q][s2] = bs[colU]; vcs[q][s2] = bc[colS]; vss[q][s2] = bs[colS]; } }
#pragma unroll
              for (int q = 0; q < 4; ++q) { const int sp = (it0 + q * NTH) >> 9; float accv = 0.f;
#pragma unroll
                  for (int s2 = 0; s2 < 4; ++s2) { const float ph = (float)((s2 * s2pv[q]) & 16383) * (1.f / 16384.f); const float cph = __builtin_amdgcn_cosf(ph), sph = __builtin_amdgcn_sinf(ph);
                      const float CU = bf2f(vcu[q][s2]), SUc = bf2f(vsu[q][s2]), CUs = hs * bf2f(vcs[q][s2]), SUs = hs * bf2f(vss[q][s2]);
                      accv += cph * (CU - sKv[q] * SUs) + sph * (-CUs - sKv[q] * SUc); }
                  HN[(size_t)sp * DM + c] = f2bf(accv * (1.f / 1024.f)); } }
          for (int it0 = TPR * 512 + gtid; it0 < T * 512; it0 += 8 * NTH) {
              unsigned short vcu[8], vss[8]; float sKv[8];
#pragma unroll
              for (int q = 0; q < 8; ++q) { const int sp = (it0 + q * NTH) >> 9; const int sq = (sp - TPR) >> 12, s1 = sp & 4095; const int k = mtok ? ((SL - s1) & (SL - 1)) : s1;
                  const bool mir = k > 2048; const int kp = mir ? 4096 - k : k; sKv[q] = mir ? -1.f : 1.f;
                  const bf16_t* bc = YCS + ((size_t)((4 + sq) * 4608 + kp)) * 512; vcu[q] = bc[colU]; vss[q] = bc[(size_t)2304 * 512 + colS]; }
#pragma unroll
              for (int q = 0; q < 8; ++q) { const int sp = (it0 + q * NTH) >> 9;
                  HN[(size_t)sp * DM + c] = f2bf((bf2f(vcu[q]) - sKv[q] * hs * bf2f(vss[q])) * (1.f / 512.f)); } }
        }
        for (int it0 = gtid; it0 < T * 8 * 16; it0 += 4 * NTH) { const int h = (it0 >> 4) & 7, c = h * 64 + (it0 & 15) * 4;
            u32x2 yf[4], yb[4], vv[4], gg[4]; float bon[4];
#pragma unroll
            for (int q = 0; q < 4; ++q) { const int t = (it0 + q * NTH) >> 7;
                yf[q] = *(const u32x2*)(YF + (size_t)t * 512 + c); yb[q] = *(const u32x2*)(YB + (size_t)t * 512 + c);
                vv[q] = *(const u32x2*)(RKV + (size_t)t * 1536 + 1024 + c); gg[q] = *(const u32x2*)(GATE + (size_t)t * 512 + c);
                bon[q] = BONUS[(size_t)t * 8 + h] + BONUS[(size_t)T * 8 + (size_t)t * 8 + h]; }
            const f32x4 lg = *(const f32x4*)(getargs()->in[15] + c), lb = *(const f32x4*)(getargs()->in[16] + c);
#pragma unroll
            for (int q = 0; q < 4; ++q) { const int t = (it0 + q * NTH) >> 7;
                f32x4 y = {bflo(yf[q].x) + bflo(yb[q].x), bfhi(yf[q].x) + bfhi(yb[q].x), bflo(yf[q].y) + bflo(yb[q].y), bfhi(yf[q].y) + bfhi(yb[q].y)};
                const float mu = red16((y[0] + y[1]) + (y[2] + y[3])) * (1.f / 64.f);
                y = y - mu; const float var = red16((y[0] * y[0] + y[1] * y[1]) + (y[2] * y[2] + y[3] * y[3])) * (1.f / 64.f);
                const float rs = rsqrtf(var + 64e-5f);
                const f32x4 v4 = {bflo(vv[q].x), bfhi(vv[q].x), bflo(vv[q].y), bfhi(vv[q].y)}, g4 = {bflo(gg[q].x), bfhi(gg[q].x), bflo(gg[q].y), bfhi(gg[q].y)};
                const f32x4 o = (y * rs * lg + lb + bon[q] * v4) * g4;
                u32x2 w; w.x = cvtpk(o[0], o[1]); w.y = cvtpk(o[2], o[3]);
                *(u32x2*)(HN + (size_t)t * DM + 512 + c) = w; } }
    }
    GSYNC();

    if (PH(5)) { PHASE_IDS;
        pg8::Gemm g{HN, W_OUT0, 1024, 1024, 1024}; pg8::Sched S; S.init(192, 4, G, bx, (size_t)256 * 2048, (size_t)256 * 2048, 1 << 20, 0);
        pg8::EpiStore E{RAWB, 1024, 0, 1.f}; pg8::gemm_phase<pg8::EpiStore, 0>(lds, g, S, E);
    }
    GSYNC();
    { PHASE_IDS; for (int m = gw; m < T; m += 2 * NGW) row_item2(xin_row(x_prompt, x_sample, m), xin_row(x_prompt, x_sample, m + NGW), RAWB + (size_t)m * DM, RAWB + (size_t)(m + NGW) * DM, getargs()->in[3], getargs()->out + (size_t)m * DM, getargs()->out + (size_t)(m + NGW) * DM, getargs()->in[27], HN + (size_t)m * DM, HN + (size_t)(m + NGW) * DM, lane); }
    GSYNC();

#pragma unroll 1
    for (int layer = 0; layer < 2; ++layer) {
        if (layer == 1) {
            REP(10) if (PH(10)) { PHASE_IDS; pg8::Gemm g{HN, W_QKV, 1024, 1024, 1024}; pg8::Sched S; S.init(192, 12, G, bx, (size_t)256 * 2048, (size_t)256 * 2048, 1 << 20, 0);
              pg8::EpiQkv E{ROPEC, ROPES, QB}; pg8::gemm_phase<pg8::EpiQkv, 0>(lds, g, S, E); }
            GSYNC();
            REP(11) if (PH(11)) {
                char* alds = (char*)lds_raw;
                for (int un = blockIdx.x; un < 1536; un += gridDim.x) {
                    int qrow0, h, kv0, seq;
                    if (un < 512) { h = un & 7; qrow0 = (un >> 3) * 256; kv0 = 0; seq = TPR; }
                    else { const int v = un - 512; h = v & 7; const int qb = v >> 3; qrow0 = TPR + qb * 256; kv0 = TPR + (qb >> 4) * SL; seq = SL; }
#pragma unroll 1
                    for (int c = 0; c < 2; ++c) {
                        f32x16 o[4]; float l_reg;
                        __syncthreads();
                        att::attn_pass(QB + (size_t)qrow0 * 1024 + h * 128 + c * 64, KB + (size_t)kv0 * 1024 + h * 128 + c * 64, VB + (size_t)kv0 * 1024 + h * 128, seq, alds, o, l_reg);
                        int tid2 = threadIdx.x; asm volatile("" : "+v"(tid2));
                        const int tidq = tid2, laneq = tidq & 63, r32 = laneq & 31, hi = laneq >> 5;
                        float* wsl = (float*)(alds + 2 * att::SHM_V + 2 * att::SHM_K) + (tidq >> 6) * 64;
                        float* tmp = (float*)(WSB + WS_ATMP) + (size_t)blockIdx.x * (64 * 512);
                        if (hi == 0) wsl[r32] = l_reg; asm volatile("s_waitcnt lgkmcnt(0)" ::: "memory");
                        float rli[16];
#pragma unroll
                        for (int r = 0; r < 16; ++r) rli[r] = __builtin_amdgcn_rcpf(wsl[att::crow(r, hi)]);
                        if (c == 0) {
#pragma unroll
                            for (int d0 = 0; d0 < 4; ++d0) { float* tp = tmp + d0 * 8192 + tidq;
#pragma unroll
                                for (int r = 0; r < 16; ++r) tp[r * 512] = o[d0][r] * rli[r];
                                __builtin_amdgcn_sched_barrier(0); }
                        } else {
                            const float l1 = wave_sum(getargs()->in[21][laneq] * getargs()->in[22][laneq]), l2 = wave_sum(getargs()->in[23][laneq] * getargs()->in[24][laneq]);
                            const float lam = __expf(l1) - __expf(l2) + LAMBDA_INIT;
                            float ssq[16];
#pragma unroll
                            for (int r = 0; r < 16; ++r) ssq[r] = 0.f;
#pragma unroll
                            for (int d0 = 0; d0 < 4; ++d0) { const float* tp = tmp + d0 * 8192 + tidq;
#pragma unroll
                                for (int r = 0; r < 16; ++r) { const float v = tp[r * 512] - lam * (o[d0][r] * rli[r]); o[d0][r] = v; ssq[r] += v * v; }
                                __builtin_amdgcn_sched_barrier(0); }
#pragma unroll
                            for (int r = 0; r < 16; ++r) { float s = ssq[r]; s += __shfl_xor(s, 1); s += __shfl_xor(s, 2); s += __shfl_xor(s, 4); s += __shfl_xor(s, 8); s += __shfl_xor(s, 16);
                                ssq[r] = rsqrtf(s * (1.f / 128.f) + 1e-5f) * (1.f - LAMBDA_INIT); }
                            bf16_t* Ow = HN + (size_t)(qrow0 + (tidq >> 6) * 32) * DM + h * 128;
#pragma unroll
                            for (int d0 = 0; d0 < 4; ++d0) { const float gsub = getargs()->in[25][d0 * 32 + r32]; bf16_t* op = Ow + (size_t)(4 * hi) * DM + d0 * 32 + r32;
#pragma unroll
                                for (int r = 0; r < 16; ++r) op[((r & 3) + 8 * (r >> 2)) * DM] = f2bf(o[d0][r] * ssq[r] * gsub);
                                __builtin_amdgcn_sched_barrier(0); }
                        }
                    }
                }
                __syncthreads();
            }
            GSYNC();
            if (PH(12)) { PHASE_IDS; pg8::Gemm g{HN, W_O, 1024, 1024, 1024}; pg8::Sched S; S.init(192, 4, G, bx, (size_t)256 * 2048, (size_t)256 * 2048, 1 << 20, 0);
              pg8::EpiStore E{RAWB, 1024, 0, 1.f}; pg8::gemm_phase<pg8::EpiStore, 0>(lds, g, S, E); }
            GSYNC();
            { PHASE_IDS; for (int m = gw; m < T; m += 2 * NGW) row_item2(getargs()->out + (size_t)m * DM, getargs()->out + (size_t)(m + NGW) * DM, RAWB + (size_t)m * DM, RAWB + (size_t)(m + NGW) * DM, getargs()->in[19], getargs()->out + (size_t)m * DM, getargs()->out + (size_t)(m + NGW) * DM, getargs()->in[27] + DM, HN + (size_t)m * DM, HN + (size_t)(m + NGW) * DM, lane); }
            GSYNC();
        }
        REP(7) if (PH(7)) { PHASE_IDS; pg8::Gemm g{HN - DM, W_UP + (size_t)layer * NUP * 1024, 1024, 1024, 1024}; pg8::Sched S; S.init(199, 22, G, bx, (size_t)248 * 2048, (size_t)256 * 2048, 1 << 20, 0);
          pg8::EpiUp E{getargs()->in[30] + (size_t)layer * 3 * NUP, getargs()->in[31] + (size_t)layer * NUP, ACT}; pg8::gemm_phase<pg8::EpiUp, 1>(lds, g, S, E); }
        GSYNC();
        REP(8) if (PH(8)) { PHASE_IDS; pg8::Gemm g{ACT, W_DN + (size_t)layer * 1024 * FF, FF, FF, FF}; pg8::Sched S; S.init(192, 4, G, bx, (size_t)256 * FF * 2, (size_t)256 * FF * 2, 1 << 20, 0);
          pg8::EpiStore E{HN, 1024, 0, 1.f}; pg8::gemm_phase<pg8::EpiStore, 0>(lds, g, S, E); }
        GSYNC();
        { PHASE_IDS; for (int m = gw; m < T; m += 2 * NGW) row_item2(getargs()->out + (size_t)m * DM, getargs()->out + (size_t)(m + NGW) * DM, HN + (size_t)m * DM, HN + (size_t)(m + NGW) * DM, getargs()->in[28] + layer * DM, getargs()->out + (size_t)m * DM, getargs()->out + (size_t)(m + NGW) * DM, layer == 0 ? getargs()->in[18] : nullptr, HN + (size_t)m * DM, HN + (size_t)(m + NGW) * DM, lane); }
        if (layer == 0) GSYNC();
    }
}

extern "C" void kernel_launch(void* const* d_in, const int* in_sizes, int n_in, void* d_out, int out_size, void* d_ws, size_t ws_size, hipStream_t stream) {
    static int grid = 0;
    if (grid == 0) {
        if (n_in != 33 || out_size != T * DM || ws_size < WS_END) { fprintf(stderr, "kernel_launch: unexpected shapes: n_in %d out %d ws %zu (need %zu)\n", n_in, out_size, ws_size, (size_t)WS_END); grid = -1; return; }
        int dev = 0, cus = 0, per_cu = 0;
        hipGetDevice(&dev); hipDeviceGetAttribute(&cus, hipDeviceAttributeMultiprocessorCount, dev);
        if (hipFuncSetAttribute((const void*)fwd_mega, hipFuncAttributeMaxDynamicSharedMemorySize, LDS_BYTES) != hipSuccess) { fprintf(stderr, "kernel_launch: hipFuncSetAttribute failed\n"); grid = -1; return; }
        hipOccupancyMaxActiveBlocksPerMultiprocessor(&per_cu, (const void*)fwd_mega, 512, LDS_BYTES);
        (void)hipGetLastError();
        if (per_cu < 1) per_cu = 1;
        grid = cus;
        if (grid > NBLK) grid = NBLK;
    }
    if (grid < 0) return;
    Args a{};
    for (int i = 0; i < 33; ++i) a.in[i] = (const float*)d_in[i];
    a.out = (float*)d_out; a.ws = (unsigned char*)d_ws;
    void* args[] = {&a};
    hipError_t e = hipLaunchCooperativeKernel((const void*)fwd_mega, dim3(grid), dim3(512), args, LDS_BYTES, stream);
    if (e != hipSuccess) fprintf(stderr, "kernel_launch: cooperative launch failed: %s (grid %d)\n", hipGetErrorString(e), grid);
}
```

```cpp
#include <hip/hip_runtime.h>
#include <hip/hip_cooperative_groups.h>
#include <cstdio>
#include <cstdint>
namespace cg = cooperative_groups;

#define DI __device__ __forceinline__
#define LAS __attribute__((address_space(3)))
typedef unsigned short bf16_t;
typedef short bf16x8 __attribute__((ext_vector_type(8)));
typedef short s16x4 __attribute__((ext_vector_type(4)));
typedef float f32x2 __attribute__((ext_vector_type(2)));
typedef float f32x4 __attribute__((ext_vector_type(4)));
typedef float f32x16 __attribute__((ext_vector_type(16)));
typedef unsigned u32x2 __attribute__((ext_vector_type(2)));
typedef unsigned u32x4 __attribute__((ext_vector_type(4)));

constexpr int T = 49152, DM = 1024, TPR = 16384, SL = 4096;
constexpr int NIN = 2560;
constexpr int ZR = 1920, MIXIN = 2432;
constexpr int FF = 2816, NUP = 5632;
constexpr int NBLK = 256;
constexpr float LAMBDA_INIT = 0.35550906759f;

constexpr size_t MiB = 1u << 20;
constexpr size_t WS_WIN = 1 * MiB, WS_WG = 7 * MiB, WS_WOUT0 = 8 * MiB, WS_WUP = 10 * MiB, WS_WDN = 32 * MiB, WS_WQKV = 43 * MiB, WS_WO = 49 * MiB;
constexpr size_t WS_ROPE = 51 * MiB, WS_BONUS = 55 * MiB, WS_DFT = 58 * MiB, WS_HNRAW = 122 * MiB, WS_B = 220 * MiB, WS_END = 512 * MiB;
constexpr size_t WS_HN = WS_HNRAW + 256 * 2048;
constexpr size_t WS_RKV = WS_B, WS_LD = WS_B + 144 * MiB, WS_GATE = WS_B + 180 * MiB, WS_YC = WS_B + 228 * MiB;
constexpr size_t WS_RAWB = WS_B, WS_ACT = WS_B, WS_Q = WS_B, WS_K = WS_B + 96 * MiB, WS_V = WS_B + 192 * MiB;
constexpr size_t WS_ATMP = WS_DFT;
constexpr size_t DO_UTS = 0, DO_UTP = 64 * MiB, DO_YF = 0, DO_YB = 48 * MiB, DO_SC = 146 * MiB, DO_SS = 166 * MiB;

constexpr int LDS_BYTES = 147456;
#ifndef PHMASK
#define PHMASK 0xFFFF
#endif
#define PH(k) ((PHMASK >> (k)) & 1)
#ifndef DUPMASK
#define DUPMASK 0
#endif
#define REP(k) for (int rep_ = 0; rep_ < 1 + ((DUPMASK >> (k)) & 1); ++rep_)

struct Args { const float* in[33]; float* out; unsigned char* ws; };

DI unsigned cvtpk(float lo, float hi) { unsigned r; asm volatile("v_cvt_pk_bf16_f32 %0, %1, %2" : "=v"(r) : "v"(lo), "v"(hi)); return r; }
DI unsigned short f2bf(float f) { return (unsigned short)(cvtpk(f, f) & 0xffffu); }
DI float bf2f(unsigned h) { return __uint_as_float(h << 16); }
DI float bflo(unsigned w) { return __uint_as_float(w << 16); }
DI float bfhi(unsigned w) { return __uint_as_float(w & 0xffff0000u); }
DI float dppf(float v, const int ctrl) { return v; }
#define DPPF(v, ctrl) __builtin_bit_cast(float, __builtin_amdgcn_update_dpp(0, __builtin_bit_cast(int, (v)), (ctrl), 0xf, 0xf, true))
DI float red8(float v) { v += DPPF(v, 0xB1); v += DPPF(v, 0x4E); v += DPPF(v, 0x141); return v; }
DI float red16(float v) { v = red8(v); v += DPPF(v, 0x128); return v; }
DI float wave_sum(float v) {
#pragma unroll
    for (int o = 1; o < 64; o <<= 1) v += __shfl_xor(v, o);
    return v;
}
DI float sigmoidf_(float x) { return __builtin_amdgcn_rcpf(1.f + __expf(-x)); }
DI bool is_first(int t) { return t == 0 || (t >= TPR && (t & (SL - 1)) == 0); }
DI bool is_last(int t) { return t == TPR - 1 || (t >= TPR && (t & (SL - 1)) == SL - 1); }
DI int seq_pos(int t) { return t < TPR ? t : (t & (SL - 1)); }
DI const float* xin_row(const float* xp, const float* xs, int t) { return t < TPR ? xp + (size_t)t * DM : xs + (size_t)(t - TPR) * DM; }

namespace pg8 {
constexpr int BM = 256, BK = 64, HALF = 128, HTB = HALF * BK * 2, NXCD = 8, WGM = 8;
DI int lds_byte(int r, int c) { const int st = (r >> 4) * 2 + (c >> 5), rr = r & 15, cc = c & 31, ob = rr * 64 + cc * 2; return st * 1024 + (ob ^ (((ob >> 9) & 1) << 5)); }
DI void stage_rc(int b, int& R, int& C) { const int st = b / 1024, sb = b % 1024, swz = sb ^ (((sb >> 9) & 1) << 5); R = (st >> 1) * 16 + swz / 64; C = (st & 1) * 32 + (swz % 64) / 2; }
DI int perm32(int rho) { const int n = rho >> 4, i = rho & 15; return 8 * (i >> 2) + 4 * n + (i & 3); }

struct Unit { int pm, pn; };
struct Gemm { const bf16_t* A; const bf16_t* Bt; int K, lda, ldb; };

struct Sched {
    int nM, nN, nwg, G, c, tpb; size_t a_tstep, b_tstep, b_batch;
    DI void init(int nM_, int nN_, int G_, int c_, size_t a_tstep_, size_t b_tstep_, int tpb_, size_t b_batch_) {
        nM = nM_; nN = nN_; nwg = nM * nN; G = G_; c = c_; a_tstep = a_tstep_; b_tstep = b_tstep_; tpb = tpb_; b_batch = b_batch_; }
    DI bool next(int i, Unit& u) const {
        const long L = (long)i * G + c; if (L >= nwg) return false;
        int wgid = (int)L; { const int q = nwg / NXCD, r = nwg % NXCD, xcd = wgid % NXCD, off = wgid / NXCD; wgid = (xcd < r ? xcd * (q + 1) : r * (q + 1) + (xcd - r) * q) + off; }
        const int nig = WGM * nN, gid = wgid / nig, fm = gid * WGM, gsz = (nM - fm) < WGM ? (nM - fm) : WGM;
        u.pm = fm + ((wgid % nig) % gsz); u.pn = (wgid % nig) / gsz; return true;
    }
    DI size_t aoff(const Unit& u) const { return (size_t)(u.pm % tpb) * a_tstep; }
    DI size_t boff(const Unit& u) const { return (size_t)(u.pm / tpb) * b_batch + (size_t)u.pn * b_tstep; }
};

template <class Epi, int OVL>
DI void gemm_phase(LAS unsigned char* lds, const Gemm g, const Sched& S, const Epi& E) {
    int tid_ = threadIdx.x; asm volatile("" : "+v"(tid_));
    const int tid = tid_, wid = __builtin_amdgcn_readfirstlane(tid >> 6), lane = tid & 63, wr = wid >> 2, wc = wid & 3, fr = lane & 15, fq = lane >> 4;
    const int K = g.K, nt = K / BK;
    unsigned voffA[2], voffB[2];
#pragma unroll
    for (int i = 0; i < 2; ++i) { int R, C; stage_rc(tid * 16 + i * 8192, R, C); const int Rb = (R & ~31) + perm32(R & 31);
        const int Ra = OVL ? ((R >> 6) * 62 + (R & 63)) : R;
        voffA[i] = (unsigned)(Ra * g.lda + C) * 2u; voffB[i] = (unsigned)(Rb * g.ldb + C) * 2u; }
    const size_t kstep = (size_t)(BK * 2);
    const size_t hstepA = (size_t)(OVL ? 124 : 128) * g.lda * 2, hstepB = (size_t)HALF * g.ldb * 2;
    const unsigned ldsw = (unsigned)wid * 1024u;
    const int aoff = lds_byte(wr * 64 + fr, fq * 8), boff = lds_byte(wc * 32 + fr, fq * 8);
#define PG8_SA(b, h) (((b) * 2 + (h)) * HTB)
#define PG8_SB(b, h) ((4 + (b) * 2 + (h)) * HTB)
#define PG8_STAGE(bufoff, gbase, voff) do { _Pragma("unroll") for (int _i = 0; _i < 2; ++_i) \
        __builtin_amdgcn_global_load_lds((const unsigned*)((const char*)(gbase) + (voff)[_i]), (LAS unsigned*)(lds + (bufoff) + ldsw + _i * 8192), 16, 0, 0); } while (0)
#define PG8_LDA(dst, b, h) do { _Pragma("unroll") for (int m = 0; m < 4; ++m) _Pragma("unroll") for (int k = 0; k < 2; ++k) dst[m][k] = *(const LAS bf16x8*)(lds + PG8_SA(b, h) + aoff + m * 2048 + k * 1024); } while (0)
#define PG8_LDB(dst, b, h) do { _Pragma("unroll") for (int n = 0; n < 2; ++n) _Pragma("unroll") for (int k = 0; k < 2; ++k) dst[n][k] = *(const LAS bf16x8*)(lds + PG8_SB(b, h) + boff + n * 2048 + k * 1024); } while (0)
#define PG8_MMA(ai, bj, At, Bt) do { __builtin_amdgcn_s_setprio(1); _Pragma("unroll") for (int m = 0; m < 4; ++m) _Pragma("unroll") for (int n = 0; n < 2; ++n) _Pragma("unroll") for (int k = 0; k < 2; ++k) \
        acc[ai][bj][m][n] = __builtin_amdgcn_mfma_f32_16x16x32_bf16(Bt[n][k], At[m][k], acc[ai][bj][m][n], 0, 0, 0); __builtin_amdgcn_s_setprio(0); } while (0)
#define PG8_WAIT_V(n) asm volatile("s_waitcnt vmcnt(" #n ")" ::: "memory")
#define PG8_WAIT_L(n) asm volatile("s_waitcnt lgkmcnt(" #n ")" ::: "memory")
#define PG8_BAR __builtin_amdgcn_s_barrier()
#define PG8_SCHED __builtin_amdgcn_sched_barrier(0)
    Unit cur, nxt; int ui = 0;
    if (!S.next(0, cur)) return;
    f32x4 acc[2][2][4][2];
#pragma unroll
    for (int a = 0; a < 2; ++a)
#pragma unroll
        for (int b = 0; b < 2; ++b)
#pragma unroll
            for (int m = 0; m < 4; ++m)
#pragma unroll
                for (int n = 0; n < 2; ++n) acc[a][b][m][n] = (f32x4){0.f, 0.f, 0.f, 0.f};
    bf16x8 At[4][2], B0[2][2], B1[2][2];
    const char* cA = (const char*)g.A + S.aoff(cur); const char* cB = (const char*)g.Bt + S.boff(cur);
    PG8_STAGE(PG8_SB(0, 0), cB, voffB); PG8_STAGE(PG8_SB(0, 1), cB + hstepB, voffB); PG8_STAGE(PG8_SA(0, 0), cA, voffA); PG8_STAGE(PG8_SA(0, 1), cA + hstepA, voffA);
    if (wr == 1) PG8_BAR;
    PG8_WAIT_V(2); PG8_BAR;
    PG8_STAGE(PG8_SB(1, 0), cB + kstep, voffB); PG8_STAGE(PG8_SA(1, 0), cA + kstep, voffA); PG8_STAGE(PG8_SB(1, 1), cB + hstepB + kstep, voffB);
    PG8_WAIT_V(6); PG8_BAR;
    for (;;) {
        const bool has_next = S.next(ui + 1, nxt);
        const char* nA = has_next ? (const char*)g.A + S.aoff(nxt) : cA; const char* nB = has_next ? (const char*)g.Bt + S.boff(nxt) : cB;
        for (int t = 0; t < nt; t += 2) {
            const bool last = (t == nt - 2);
            const char* a1 = cA + (size_t)(t + 1) * kstep;
            const char* a2 = last ? nA : cA + (size_t)(t + 2) * kstep; const char* b2 = last ? nB : cB + (size_t)(t + 2) * kstep;
            const char* a3 = a2 + kstep; const char* b3 = b2 + kstep;
            PG8_LDB(B0, 0, 0); PG8_LDB(B1, 0, 1); PG8_SCHED; PG8_LDA(At, 0, 0); PG8_STAGE(PG8_SA(1, 1), a1 + hstepA, voffA);
            PG8_WAIT_V(8); PG8_WAIT_L(0); PG8_BAR; PG8_MMA(0, 0, At, B0); PG8_MMA(0, 1, At, B1); PG8_BAR; PG8_SCHED;
            PG8_LDA(At, 0, 1); PG8_STAGE(PG8_SB(0, 0), b2, voffB); PG8_STAGE(PG8_SB(0, 1), b2 + hstepB, voffB); PG8_STAGE(PG8_SA(0, 0), a2, voffA);
            PG8_WAIT_V(8); PG8_WAIT_L(0); PG8_BAR; PG8_MMA(1, 0, At, B0); PG8_MMA(1, 1, At, B1); PG8_BAR; PG8_SCHED;
            PG8_LDB(B0, 1, 0); PG8_LDB(B1, 1, 1); PG8_SCHED; PG8_LDA(At, 1, 0); PG8_STAGE(PG8_SA(0, 1), a2 + hstepA, voffA);
            PG8_WAIT_V(8); PG8_WAIT_L(0); PG8_BAR; PG8_MMA(0, 0, At, B0); PG8_MMA(0, 1, At, B1); PG8_BAR; PG8_SCHED;
            PG8_LDA(At, 1, 1); PG8_STAGE(PG8_SB(1, 0), b3, voffB); PG8_STAGE(PG8_SB(1, 1), b3 + hstepB, voffB); PG8_STAGE(PG8_SA(1, 0), a3, voffA);
            PG8_WAIT_V(8); PG8_WAIT_L(0); PG8_BAR; PG8_MMA(1, 0, At, B0); PG8_MMA(1, 1, At, B1); PG8_BAR; PG8_SCHED;
        }
        if (wr == 0) PG8_BAR;
        E(acc, cur, wr, wc, fr, fq);
        if (!has_next) break;
#pragma unroll
        for (int a = 0; a < 2; ++a)
#pragma unroll
            for (int b = 0; b < 2; ++b)
#pragma unroll
                for (int m = 0; m < 4; ++m)
#pragma unroll
                    for (int n = 0; n < 2; ++n) acc[a][b][m][n] = (f32x4){0.f, 0.f, 0.f, 0.f};
        cur = nxt; cA = nA; cB = nB; ++ui;
        if (wr == 1) PG8_BAR;
    }
    PG8_WAIT_V(0);
    PG8_BAR;
#undef PG8_SA
#undef PG8_SB
#undef PG8_STAGE
#undef PG8_LDA
#undef PG8_LDB
#undef PG8_MMA
#undef PG8_WAIT_V
#undef PG8_WAIT_L
#undef PG8_BAR
#undef PG8_SCHED
}

struct EpiStore {
    bf16_t* O; int ldc; int row_off; float scale;
    DI void operator()(const f32x4 (&acc)[2][2][4][2], const Unit& u, int wr, int wc, int fr, int fq) const {
        const int row0 = row_off + u.pm * BM + wr * 64 + fr, col0 = u.pn * BM + wc * 32 + 8 * fq;
#pragma unroll
        for (int ai = 0; ai < 2; ++ai)
#pragma unroll
            for (int m = 0; m < 4; ++m) { bf16_t* rowp = O + (size_t)(row0 + ai * HALF + m * 16) * ldc + col0;
#pragma unroll
                for (int bj = 0; bj < 2; ++bj) { const f32x4 v0 = acc[ai][bj][m][0] * scale, v1 = acc[ai][bj][m][1] * scale;
                    u32x4 w; w.x = cvtpk(v0[0], v0[1]); w.y = cvtpk(v0[2], v0[3]); w.z = cvtpk(v1[0], v1[1]); w.w = cvtpk(v1[2], v1[3]);
                    *(u32x4*)(rowp + bj * HALF) = w; } }
    }
};

DI f32x4 shfl4(f32x4 v, int src) { f32x4 r; r.x = __shfl(v.x, src); r.y = __shfl(v.y, src); r.z = __shfl(v.z, src); r.w = __shfl(v.w, src); return r; }

#define CONV_COL(ACC, AI, BJ, N, Z, CP, CM, CN) do { const f32x4 zero4_ = {0.f, 0.f, 0.f, 0.f}; \
    _Pragma("unroll") for (int m = 0; m < 4; ++m) { const f32x4 cur_ = ACC[AI][BJ][m][N]; \
        const f32x4 su_ = (fr == 15) ? (m > 0 ? ACC[AI][BJ][m > 0 ? m - 1 : 0][N] : zero4_) : cur_; \
        const f32x4 sd_ = (fr == 0) ? (m < 3 ? ACC[AI][BJ][m < 3 ? m + 1 : 3][N] : zero4_) : cur_; \
        f32x4 up_ = shfl4(su_, src_up), dn_ = shfl4(sd_, src_dn); \
        const int t_ = tok0 + 16 * m + fr; \
        if (is_first(t_)) up_ = zero4_; if (is_last(t_)) dn_ = zero4_; \
        Z[m] = CP * up_ + CM * cur_ + CN * dn_; } } while (0)
#define CONV_ONE(ACC, AI, BJ, N, M, Z, CP, CM, CN) do { const f32x4 zero4_ = {0.f, 0.f, 0.f, 0.f}; const f32x4 cur_ = ACC[AI][BJ][M][N]; \
        const f32x4 su_ = (fr == 15) ? (M > 0 ? ACC[AI][BJ][M > 0 ? M - 1 : 0][N] : zero4_) : cur_; \
        const f32x4 sd_ = (fr == 0) ? (M < 3 ? ACC[AI][BJ][M < 3 ? M + 1 : 3][N] : zero4_) : cur_; \
        f32x4 up_ = shfl4(su_, src_up), dn_ = shfl4(sd_, src_dn); \
        const int t_ = tok0 + 16 * M + fr; \
        if (is_first(t_)) up_ = zero4_; if (is_last(t_)) dn_ = zero4_; \
        Z = CP * up_ + CM * cur_ + CN * dn_; } while (0)
#define ROW_VALID(m) ((16 * (m) + fr >= 1) && (16 * (m) + fr <= 62) && (tok0 + 16 * (m) + fr < T))

struct EpiIn {
    const float* mu_prev; const float* mu_next; bf16_t* UTS_; bf16_t* UTP_; bf16_t* RKV_; bf16_t* LD_;
    DI void operator()(const f32x4 (&acc)[2][2][4][2], const Unit& u, int wr, int wc, int fr_, int fq_) const {
        int fr = fr_, fq = fq_; asm volatile("" : "+v"(fr), "+v"(fq));
        const int lane = fr | (fq << 4);
        const int src_up = (lane & 48) | ((fr + 15) & 15), src_dn = (lane & 48) | ((fr + 1) & 15);
        if (u.pn < 2) {
#pragma unroll
            for (int ai = 0; ai < 2; ++ai) {
                const int tok0 = u.pm * 248 + (2 * ai + wr) * 62 - 1;
#pragma unroll
                for (int m = 0; m < 4; ++m) {
                    if (ROW_VALID(m)) { const int t = tok0 + 16 * m + fr; const bool smp = t >= TPR;
                        const int s_ = smp ? (t & (SL - 1)) : (t >> 2); const int rb = (smp ? 4 + ((t - TPR) >> 12) : (t & 3)) * 512;
#pragma unroll
                        for (int bj = 0; bj < 2; ++bj) { const int c0 = u.pn * BM + bj * HALF + wc * 32 + 8 * fq;
#pragma unroll
                            for (int n = 0; n < 2; ++n)
#pragma unroll
                                for (int e = 0; e < 4; ++e) UTS_[((size_t)(rb + c0 + 4 * n + e)) * 4096 + s_] = f2bf(acc[ai][bj][m][n][e]); }
                    }
                    __builtin_amdgcn_sched_barrier(0); }
            }
        } else {
#pragma unroll
            for (int bj = 0; bj < 2; ++bj) {
                const int zc0 = u.pn * BM + bj * HALF + wc * 32 + 8 * fq - 512;
                if (zc0 >= ZR) continue;
                const int act = zc0 < 1536 ? 0 : (zc0 < 1664 ? 1 : (zc0 < 1792 ? 0 : 2));
#pragma unroll
                for (int n = 0; n < 2; ++n) { const f32x4 cp = *(const f32x4*)(mu_prev + zc0 + 4 * n), cn = *(const f32x4*)(mu_next + zc0 + 4 * n); const f32x4 cm = 1.f - cp - cn;
#pragma unroll
                    for (int ai = 0; ai < 2; ++ai) {
                        const int tok0 = u.pm * 248 + (2 * ai + wr) * 62 - 1;
#pragma unroll
                        for (int m = 0; m < 4; ++m) { f32x4 z;
                            CONV_ONE(acc, ai, bj, n, m, z, cp, cm, cn);
                            if (act == 1) {
#pragma unroll
                                for (int e = 0; e < 4; ++e) z[e] = 1.f - 2.f * __builtin_amdgcn_rcpf(1.f + __expf(2.f * z[e])); }
                            if (act == 2) {
#pragma unroll
                                for (int e = 0; e < 4; ++e) z[e] = sigmoidf_(z[e]); }
                            if (ROW_VALID(m)) { const int t = tok0 + 16 * m + fr; u32x2 w; w.x = cvtpk(z[0], z[1]); w.y = cvtpk(z[2], z[3]);
                                if (zc0 < 1536) *(u32x2*)(RKV_ + (size_t)t * 1536 + zc0 + 4 * n) = w; else *(u32x2*)(LD_ + (size_t)t * 384 + (zc0 - 1536) + 4 * n) = w; }
                            __builtin_amdgcn_sched_barrier(0); }
                    }
                }
            }
        }
    }
};

struct EpiUp {
    const float* cw; const float* cb; bf16_t* ACT;
    DI void operator()(const f32x4 (&acc)[2][2][4][2], const Unit& u, int wr, int wc, int fr_, int fq_) const {
        int fr = fr_, fq = fq_; asm volatile("" : "+v"(fr), "+v"(fq));
        const int lane = fr | (fq << 4);
        const int src_up = (lane & 48) | ((fr + 15) & 15), src_dn = (lane & 48) | ((fr + 1) & 15);
        const int cv0 = u.pn * 128 + wc * 32 + 8 * fq;
#pragma unroll
        for (int n = 0; n < 2; ++n) {
            const int sv = cv0 + 4 * n, sg = FF + cv0 + 4 * n;
            const f32x4 vp = *(const f32x4*)(cw + sv), vm = *(const f32x4*)(cw + NUP + sv), vn = *(const f32x4*)(cw + 2 * NUP + sv), vb = *(const f32x4*)(cb + sv);
            const f32x4 gp = *(const f32x4*)(cw + sg), gm = *(const f32x4*)(cw + NUP + sg), gn = *(const f32x4*)(cw + 2 * NUP + sg), gb = *(const f32x4*)(cb + sg);
#pragma unroll
            for (int ai = 0; ai < 2; ++ai) {
                const int tok0 = u.pm * 248 + (2 * ai + wr) * 62 - 1;
#pragma unroll
                for (int m = 0; m < 4; ++m) { f32x4 zv, zg;
                    CONV_ONE(acc, ai, 0, n, m, zv, vp, vm, vn); CONV_ONE(acc, ai, 1, n, m, zg, gp, gm, gn);
                    zv = zv + vb; zg = zg + gb;
                    float ov[4];
#pragma unroll
                    for (int e = 0; e < 4; ++e) { const float x = zg[e]; const float uu = 1.5957691216f * (x + 0.044715f * x * x * x);
                        ov[e] = zv[e] * x * __builtin_amdgcn_rcpf(1.f + __expf(-uu)); }
                    if (ROW_VALID(m)) { const int t = tok0 + 16 * m + fr; u32x2 w; w.x = cvtpk(ov[0], ov[1]); w.y = cvtpk(ov[2], ov[3]);
                        *(u32x2*)(ACT + (size_t)t * FF + cv0 + 4 * n) = w; }
                    __builtin_amdgcn_sched_barrier(0); }
            }
        }
    }
};

struct EpiQkv {
    const float* ropec; const float* ropes; bf16_t* Q;
    DI void operator()(const f32x4 (&acc)[2][2][4][2], const Unit& u, int wr, int wc, int fr_, int fq_) const {
        int fr = fr_, fq = fq_; asm volatile("" : "+v"(fr), "+v"(fq));
        const int which = u.pn >> 2;
        bf16_t* base = Q + (size_t)which * ((size_t)T * 1024);
        const int i0 = 16 * (wc & 1) + 4 * fq;
#pragma unroll
        for (int ai = 0; ai < 2; ++ai)
#pragma unroll
            for (int m = 0; m < 4; ++m) { const int t = u.pm * BM + ai * HALF + wr * 64 + m * 16 + fr;
                f32x4 c4 = (f32x4){1.f, 1.f, 1.f, 1.f}, s4 = (f32x4){0.f, 0.f, 0.f, 0.f};
                if (which < 2) { const int pos = seq_pos(t); c4 = *(const f32x4*)(ropec + pos * 32 + i0); s4 = *(const f32x4*)(ropes + pos * 32 + i0); }
#pragma unroll
                for (int bj = 0; bj < 2; ++bj) { const f32x4 x1 = acc[ai][bj][m][0], x2 = acc[ai][bj][m][1];
                    f32x4 y1 = x1, y2 = x2;
                    if (which < 2) { y1 = x1 * c4 - x2 * s4; y2 = x2 * c4 + x1 * s4; }
                    if (which == 0) { y1 = y1 * (0.125f * 1.4426950408889634f); y2 = y2 * (0.125f * 1.4426950408889634f); }
                    u32x4 w; w.x = cvtpk(y1[0], y1[1]); w.y = cvtpk(y1[2], y1[3]); w.z = cvtpk(y2[0], y2[1]); w.w = cvtpk(y2[2], y2[3]);
                    *(u32x4*)(base + (size_t)t * 1024 + (u.pn & 3) * BM + bj * HALF + wc * 32 + 8 * fq) = w; } }
    }
};
}

namespace att {
constexpr int NW = 8, QBLK = 32, KVBLK = 64, LDQ = 1024;
constexpr float SCALE = 0.125f, THR = 8.f;
constexpr int SHM_V = KVBLK * 128 * 2, SHM_K = KVBLK * 64 * 2;
#define KSWZ(row, colB) ((row) * 128 + ((colB) ^ ((((row) >> 1) & 7) << 4)))
#define SBAR() __builtin_amdgcn_sched_barrier(0)
DI int crow(int r, int hi) { return (r & 3) + 8 * (r >> 2) + 4 * hi; }
DI void partialSM(f32x16& p0, f32x16& p1, float& m_reg, f32x16& negm, float& alpha) {
    constexpr float THR2 = THR * 1.4426950408889634f;
    float pmax = p0[0];
#pragma unroll
    for (int r = 1; r < 16; ++r) pmax = fmaxf(pmax, p0[r]);
#pragma unroll
    for (int r = 0; r < 16; ++r) pmax = fmaxf(pmax, p1[r]);
    { auto rr = __builtin_amdgcn_permlane32_swap(__float_as_uint(pmax), __float_as_uint(pmax), false, false);
      pmax = fmaxf(__uint_as_float(rr[0]), __uint_as_float(rr[1])); }
    const bool first = m_reg < -1e29f;
    if (__builtin_expect(__all(!first && pmax <= THR2), 1)) { alpha = 1.f; }
    else {
        const float d = first ? pmax : fmaxf(pmax, 0.f);
        alpha = first ? 0.f : __builtin_amdgcn_exp2f(-d);
        m_reg = first ? pmax : m_reg + d;
#pragma unroll
        for (int r = 0; r < 16; ++r) { p0[r] -= d; p1[r] -= d; negm[r] = -m_reg; }
    }
#pragma unroll
    for (int r = 0; r < 16; ++r) p0[r] = __builtin_amdgcn_exp2f(p0[r]);
}
DI void finishSM(f32x16& p0, f32x16& p1, float alpha, float& l_reg, bf16x8& pa0, bf16x8& pa1, bf16x8& pa2, bf16x8& pa3) {
#pragma unroll
    for (int r = 0; r < 16; ++r) p1[r] = __builtin_amdgcn_exp2f(p1[r]);
    float ps = 0;
#pragma unroll
    for (int r = 0; r < 16; ++r) ps += p0[r];
#pragma unroll
    for (int r = 0; r < 16; ++r) ps += p1[r];
    { auto rr = __builtin_amdgcn_permlane32_swap(__float_as_uint(ps), __float_as_uint(ps), false, false);
      ps = __uint_as_float(rr[0]) + __uint_as_float(rr[1]); }
    l_reg = l_reg * alpha + ps;
#define PK4(P, BASE, OUT) do { unsigned a0 = cvtpk(P[BASE + 0], P[BASE + 1]), a1 = cvtpk(P[BASE + 2], P[BASE + 3]);   \
    unsigned b0 = cvtpk(P[BASE + 4], P[BASE + 5]), b1 = cvtpk(P[BASE + 6], P[BASE + 7]);                              \
    auto r0 = __builtin_amdgcn_permlane32_swap(a0, b0, false, false); auto r1 = __builtin_amdgcn_permlane32_swap(a1, b1, false, false); \
    u32x4 w = {r0[0], r1[0], r0[1], r1[1]}; OUT = __builtin_bit_cast(bf16x8, w); } while (0)
    PK4(p0, 0, pa0); PK4(p0, 8, pa1); PK4(p1, 0, pa2); PK4(p1, 8, pa3);
#undef PK4
}
DI void qkt(f32x16& p0, f32x16& p1, const char* Ks, const bf16x8* qr, const f32x16& negm, int r32, int hi) {
    { const bf16x8 b0 = *reinterpret_cast<const bf16x8*>(Ks + KSWZ(r32, hi * 16));
      const bf16x8 b1 = *reinterpret_cast<const bf16x8*>(Ks + KSWZ(32 + r32, hi * 16));
      p0 = __builtin_amdgcn_mfma_f32_32x32x16_bf16(b0, qr[0], negm, 0, 0, 0);
      p1 = __builtin_amdgcn_mfma_f32_32x32x16_bf16(b1, qr[0], negm, 0, 0, 0); }
#pragma unroll
    for (int d0 = 1; d0 < 4; ++d0) { const int cb = (d0 * 16 + hi * 8) * 2;
        const bf16x8 b0 = *reinterpret_cast<const bf16x8*>(Ks + KSWZ(r32, cb));
        const bf16x8 b1 = *reinterpret_cast<const bf16x8*>(Ks + KSWZ(32 + r32, cb));
        p0 = __builtin_amdgcn_mfma_f32_32x32x16_bf16(b0, qr[d0], p0, 0, 0, 0);
        p1 = __builtin_amdgcn_mfma_f32_32x32x16_bf16(b1, qr[d0], p1, 0, 0, 0); }
}
DI int v_st(int k, int c) { const int kk = (k & ~0xC) | ((k & 4) << 1) | ((k & 8) >> 1); return ((kk >> 3) * 4 + (c >> 5)) * 512 + ((kk & 7) * 32 + (c & 31)) * 2; }
DI int v_rd_base(int lane) { return ((lane & 3) << 3) | (((lane >> 2) & 3) << 6) | (((lane >> 4) & 1) << 5) | (((lane >> 5) & 1) << 8); }
constexpr int v_rd_off(int d0, int ks, int half) { return d0 * 512 + ks * 4096 + half * 2048; }
template <int OFF> DI s16x4 tr_read(int vb) { s16x4 r; asm volatile("ds_read_b64_tr_b16 %0, %1 offset:%2" : "=&v"(r) : "v"(vb), "i"(OFF) : "memory"); return r; }
template <int D0> DI void pv_one(f32x16& od, int vb, bf16x8 pa0, bf16x8 pa1, bf16x8 pa2, bf16x8 pa3) {
    const s16x4 l0 = tr_read<v_rd_off(D0, 0, 0)>(vb), h0 = tr_read<v_rd_off(D0, 0, 1)>(vb), l1 = tr_read<v_rd_off(D0, 1, 0)>(vb), h1 = tr_read<v_rd_off(D0, 1, 1)>(vb);
    const s16x4 l2 = tr_read<v_rd_off(D0, 2, 0)>(vb), h2 = tr_read<v_rd_off(D0, 2, 1)>(vb), l3 = tr_read<v_rd_off(D0, 3, 0)>(vb), h3 = tr_read<v_rd_off(D0, 3, 1)>(vb);
    asm volatile("s_waitcnt lgkmcnt(0)" ::: "memory"); SBAR();
#define PKV(L, H) (bf16x8){L[0], L[1], L[2], L[3], H[0], H[1], H[2], H[3]}
    od = __builtin_amdgcn_mfma_f32_32x32x16_bf16(pa0, PKV(l0, h0), od, 0, 0, 0);
    od = __builtin_amdgcn_mfma_f32_32x32x16_bf16(pa1, PKV(l1, h1), od, 0, 0, 0);
    od = __builtin_amdgcn_mfma_f32_32x32x16_bf16(pa2, PKV(l2, h2), od, 0, 0, 0);
    od = __builtin_amdgcn_mfma_f32_32x32x16_bf16(pa3, PKV(l3, h3), od, 0, 0, 0);
#undef PKV
}
DI void pv_d0(f32x16* o, int vb, bf16x8 pa0, bf16x8 pa1, bf16x8 pa2, bf16x8 pa3) {
    pv_one<0>(o[0], vb, pa0, pa1, pa2, pa3); pv_one<1>(o[1], vb, pa0, pa1, pa2, pa3); pv_one<2>(o[2], vb, pa0, pa1, pa2, pa3); pv_one<3>(o[3], vb, pa0, pa1, pa2, pa3);
}

DI void attn_pass(const bf16_t* __restrict__ Qb, const bf16_t* __restrict__ Kh, const bf16_t* __restrict__ Vh, int seq, char* lds, f32x16 (&o)[4], float& l_out) {
    int tid_ = threadIdx.x; asm volatile("" : "+v"(tid_));
    const int tid = tid_, wid = tid >> 6, lane = tid & 63, r32 = lane & 31, hi = lane >> 5;
    char* V_lds = lds; char* K_lds = lds + 2 * SHM_V;
    float* ws = (float*)(lds + 2 * SHM_V + 2 * SHM_K) + wid * 64; float* al_l = ws + 32;
    float m_reg = -1e30f, l_reg = 0; bf16x8 qr[4]; f32x16 negm;
#pragma unroll
    for (int r = 0; r < 16; ++r) negm[r] = 0.f;
#pragma unroll
    for (int d = 0; d < 4; ++d)
#pragma unroll
        for (int r = 0; r < 16; ++r) o[d][r] = 0.f;
    const bf16_t* Qw = Qb + (size_t)(wid * QBLK + r32) * LDQ + hi * 8;
#pragma unroll
    for (int d0 = 0; d0 < 4; ++d0) qr[d0] = *reinterpret_cast<const bf16x8*>(Qw + d0 * 16);
    const int sr = tid >> 4, sc = (tid & 15) * 8, vst0 = v_st(sr, sc), vst1 = v_st(32 + sr, sc);
    const int kr = tid >> 3, kc = (tid & 7) * 8, kst = KSWZ(kr, kc * 2);
    const int vb0 = (int)(uintptr_t)V_lds + v_rd_base(lane);
    bf16x8 vsA0, vsA1, ksA, vsB0, vsB1, ksB;
#define SLOADA(k0) do { vsA0 = *reinterpret_cast<const bf16x8*>(&Vh[(size_t)((k0) + sr) * LDQ + sc]); vsA1 = *reinterpret_cast<const bf16x8*>(&Vh[(size_t)((k0) + 32 + sr) * LDQ + sc]); \
    ksA = *reinterpret_cast<const bf16x8*>(&Kh[(size_t)((k0) + kr) * LDQ + kc]); } while (0)
#define SLOADB(k0) do { vsB0 = *reinterpret_cast<const bf16x8*>(&Vh[(size_t)((k0) + sr) * LDQ + sc]); vsB1 = *reinterpret_cast<const bf16x8*>(&Vh[(size_t)((k0) + 32 + sr) * LDQ + sc]); \
    ksB = *reinterpret_cast<const bf16x8*>(&Kh[(size_t)((k0) + kr) * LDQ + kc]); } while (0)
#define SWRITEA(b) do { *(bf16x8*)(V_lds + (b) * SHM_V + vst0) = vsA0; *(bf16x8*)(V_lds + (b) * SHM_V + vst1) = vsA1; *(bf16x8*)(K_lds + (b) * SHM_K + kst) = ksA; } while (0)
#define SWRITEB(b) do { *(bf16x8*)(V_lds + (b) * SHM_V + vst0) = vsB0; *(bf16x8*)(V_lds + (b) * SHM_V + vst1) = vsB1; *(bf16x8*)(K_lds + (b) * SHM_K + kst) = ksB; } while (0)
#define SWAIT() asm volatile("s_waitcnt vmcnt(3)" ::: "memory")
#define RESC(a) do { if (__any((a) < 1.f)) { if (hi == 0) al_l[r32] = (a); asm volatile("s_waitcnt lgkmcnt(0)" ::: "memory"); \
    _Pragma("unroll") for (int d = 0; d < 4; ++d) _Pragma("unroll") for (int r = 0; r < 16; ++r) o[d][r] *= al_l[crow(r, hi)]; } } while (0)
    f32x16 pA0, pA1, pB0, pB1; float alA, alB; bf16x8 pa0, pa1, pa2, pa3; const int NT = seq / KVBLK;
    SLOADA(0); asm volatile("s_waitcnt vmcnt(0)" ::: "memory"); SWRITEA(0); __syncthreads();
    qkt(pA0, pA1, K_lds, qr, negm, r32, hi); partialSM(pA0, pA1, m_reg, negm, alA);
    SLOADB(KVBLK); if (2 < NT) SLOADA(2 * KVBLK);
    SWAIT(); SWRITEB(1); __syncthreads();
    for (int j = 1; j + 1 < NT; j += 2) {
        SBAR(); qkt(pB0, pB1, K_lds + SHM_K, qr, negm, r32, hi);
        finishSM(pA0, pA1, alA, l_reg, pa0, pa1, pa2, pa3); SBAR();
        SLOADB((j + 2) * KVBLK); SBAR();
        pv_d0(o, vb0, pa0, pa1, pa2, pa3); partialSM(pB0, pB1, m_reg, negm, alB);
        __syncthreads(); SWAIT(); SWRITEA(0);
        RESC(alB); __syncthreads();
        SBAR(); qkt(pA0, pA1, K_lds, qr, negm, r32, hi);
        finishSM(pB0, pB1, alB, l_reg, pa0, pa1, pa2, pa3); SBAR();
        if (j + 3 < NT) SLOADA((j + 3) * KVBLK); SBAR();
        pv_d0(o, vb0 + SHM_V, pa0, pa1, pa2, pa3); partialSM(pA0, pA1, m_reg, negm, alA);
        __syncthreads(); if (j + 3 < NT) SWAIT(); else asm volatile("s_waitcnt vmcnt(0)" ::: "memory"); SWRITEB(1);
        RESC(alA); __syncthreads();
    }
    SBAR(); qkt(pB0, pB1, K_lds + SHM_K, qr, negm, r32, hi);
    finishSM(pA0, pA1, alA, l_reg, pa0, pa1, pa2, pa3); SBAR();
    pv_d0(o, vb0, pa0, pa1, pa2, pa3); partialSM(pB0, pB1, m_reg, negm, alB);
    __syncthreads(); RESC(alB);
    finishSM(pB0, pB1, alB, l_reg, pa0, pa1, pa2, pa3); SBAR();
    pv_d0(o, vb0 + SHM_V, pa0, pa1, pa2, pa3);
    l_out = l_reg;
#undef SLOADA
#undef SLOADB
#undef SWRITEA
#undef SWRITEB
#undef SWAIT
#undef RESC
}
}

DI void tr_item(const float* W, int ldw, int K, bf16_t* WT, int n0, int k0, int srccol, int lane, LAS float* scr) {
#pragma unroll 8
    for (int i = 0; i < 32; ++i) { const int kk = 2 * i + (lane >> 5); scr[kk * 33 + (lane & 31)] = srccol >= 0 ? W[(size_t)(k0 + kk) * ldw + srccol] : 0.f; }
    asm volatile("s_waitcnt lgkmcnt(0)" ::: "memory");
    const int c = lane & 7;
#pragma unroll
    for (int j = 0; j < 4; ++j) { const int n = (lane >> 3) + 8 * j; const LAS float* s = scr + (8 * c) * 33 + n;
        u32x4 o; o.x = cvtpk(s[0 * 33], s[1 * 33]); o.y = cvtpk(s[2 * 33], s[3 * 33]); o.z = cvtpk(s[4 * 33], s[5 * 33]); o.w = cvtpk(s[6 * 33], s[7 * 33]);
        *(u32x4*)(WT + (size_t)(n0 + n) * K + k0 + 8 * c) = o; }
    asm volatile("s_waitcnt lgkmcnt(0)" ::: "memory");
}

DI void row_item(const float* xrow, const bf16_t* hrow, const float* gpost, float* orow, const float* gpre, bf16_t* hnrow, int lane) {
    f32x4 v[4];
#pragma unroll
    for (int j = 0; j < 4; ++j) v[j] = *((const f32x4*)xrow + lane + 64 * j);
    if (hrow) {
        f32x4 h[4]; float s = 0.f;
#pragma unroll
        for (int j = 0; j < 4; ++j) { const u32x2 w = *((const u32x2*)hrow + lane + 64 * j); h[j] = (f32x4){bflo(w.x), bfhi(w.x), bflo(w.y), bfhi(w.y)};
            s += (h[j].x * h[j].x + h[j].y * h[j].y) + (h[j].z * h[j].z + h[j].w * h[j].w); }
        const float rs = rsqrtf(wave_sum(s) * (1.f / DM) + 1e-6f);
#pragma unroll
        for (int j = 0; j < 4; ++j) { const f32x4 g = *((const f32x4*)gpost + lane + 64 * j); v[j] = v[j] + h[j] * rs * g; *((f32x4*)orow + lane + 64 * j) = v[j]; }
    }
    if (gpre) {
        float s = 0.f;
#pragma unroll
        for (int j = 0; j < 4; ++j) s += (v[j].x * v[j].x + v[j].y * v[j].y) + (v[j].z * v[j].z + v[j].w * v[j].w);
        const float rs = rsqrtf(wave_sum(s) * (1.f / DM) + 1e-6f);
#pragma unroll
        for (int j = 0; j < 4; ++j) { const f32x4 g = *((const f32x4*)gpre + lane + 64 * j); const f32x4 y = v[j] * rs * g;
            u32x2 w; w.x = cvtpk(y.x, y.y); w.y = cvtpk(y.z, y.w); *((u32x2*)hnrow + lane + 64 * j) = w; }
    }
}

DI void row_item2(const float* xa, const float* xb, const bf16_t* ha, const bf16_t* hb, const float* gpost, float* oa, float* ob, const float* gpre, bf16_t* hna, bf16_t* hnb, int lane) {
    f32x4 va[4], vb[4]; u32x2 wa[4], wb[4];
#pragma unroll
    for (int j = 0; j < 4; ++j) { va[j] = *((const f32x4*)xa + lane + 64 * j); vb[j] = *((const f32x4*)xb + lane + 64 * j); }
    if (ha) {
#pragma unroll
        for (int j = 0; j < 4; ++j) { wa[j] = *((const u32x2*)ha + lane + 64 * j); wb[j] = *((const u32x2*)hb + lane + 64 * j); }
        f32x4 h[4]; float s = 0.f;
#pragma unroll
        for (int j = 0; j < 4; ++j) { const u32x2 w = wa[j]; h[j] = (f32x4){bflo(w.x), bfhi(w.x), bflo(w.y), bfhi(w.y)}; s += (h[j].x * h[j].x + h[j].y * h[j].y) + (h[j].z * h[j].z + h[j].w * h[j].w); }
        float rs = rsqrtf(wave_sum(s) * (1.f / DM) + 1e-6f);
#pragma unroll
        for (int j = 0; j < 4; ++j) { const f32x4 g = *((const f32x4*)gpost + lane + 64 * j); va[j] = va[j] + h[j] * rs * g; *((f32x4*)oa + lane + 64 * j) = va[j]; }
        s = 0.f;
#pragma unroll
        for (int j = 0; j < 4; ++j) { const u32x2 w = wb[j]; h[j] = (f32x4){bflo(w.x), bfhi(w.x), bflo(w.y), bfhi(w.y)}; s += (h[j].x * h[j].x + h[j].y * h[j].y) + (h[j].z * h[j].z + h[j].w * h[j].w); }
        rs = rsqrtf(wave_sum(s) * (1.f / DM) + 1e-6f);
#pragma unroll
        for (int j = 0; j < 4; ++j) { const f32x4 g = *((const f32x4*)gpost + lane + 64 * j); vb[j] = vb[j] + h[j] * rs * g; *((f32x4*)ob + lane + 64 * j) = vb[j]; }
    }
    if (gpre) {
        float s = 0.f, t = 0.f;
#pragma unroll
        for (int j = 0; j < 4; ++j) { s += (va[j].x * va[j].x + va[j].y * va[j].y) + (va[j].z * va[j].z + va[j].w * va[j].w); t += (vb[j].x * vb[j].x + vb[j].y * vb[j].y) + (vb[j].z * vb[j].z + vb[j].w * vb[j].w); }
        const float rsa = rsqrtf(wave_sum(s) * (1.f / DM) + 1e-6f), rsb = rsqrtf(wave_sum(t) * (1.f / DM) + 1e-6f);
#pragma unroll
        for (int j = 0; j < 4; ++j) { const f32x4 g = *((const f32x4*)gpre + lane + 64 * j); const f32x4 ya = va[j] * rsa * g, yb = vb[j] * rsb * g;
            u32x2 w; w.x = cvtpk(ya.x, ya.y); w.y = cvtpk(ya.z, ya.w); *((u32x2*)hna + lane + 64 * j) = w;
            u32x2 w2; w2.x = cvtpk(yb.x, yb.y); w2.y = cvtpk(yb.z, yb.w); *((u32x2*)hnb + lane + 64 * j) = w2; }
    }
}

typedef const __attribute__((address_space(4))) Args* ArgsP;
DI ArgsP getargs() { unsigned long long kp = (unsigned long long)__builtin_amdgcn_kernarg_segment_ptr(); asm volatile("" : "+s"(kp)); return (ArgsP)kp; }
#define WSB (getargs()->ws)
#define DOB ((unsigned char*)getargs()->out)
#define x_prompt (getargs()->in[0])
#define x_sample (getargs()->in[1])
#define W_IN ((bf16_t*)(WSB + WS_WIN))
#define W_G ((bf16_t*)(WSB + WS_WG))
#define W_OUT0 ((bf16_t*)(WSB + WS_WOUT0))
#define W_UP ((bf16_t*)(WSB + WS_WUP))
#define W_DN ((bf16_t*)(WSB + WS_WDN))
#define W_QKV ((bf16_t*)(WSB + WS_WQKV))
#define W_O ((bf16_t*)(WSB + WS_WO))
#define ROPEC ((float*)(WSB + WS_ROPE))
#define ROPES (ROPEC + TPR * 32)
#define BONUS ((float*)(WSB + WS_BONUS))
#define DFTM ((bf16_t*)(WSB + WS_DFT))
#define HN ((bf16_t*)(WSB + WS_HN))
#define RKV ((bf16_t*)(WSB + WS_RKV))
#define LDB ((bf16_t*)(WSB + WS_LD))
#define GATE ((bf16_t*)(WSB + WS_GATE))
#define YC ((bf16_t*)(WSB + WS_YC))
#define RAWB ((bf16_t*)(WSB + WS_RAWB))
#define ACT ((bf16_t*)(WSB + WS_ACT))
#define QB ((bf16_t*)(WSB + WS_Q))
#define KB ((bf16_t*)(WSB + WS_K))
#define VB ((bf16_t*)(WSB + WS_V))
#define UTS ((bf16_t*)(DOB + DO_UTS))
#define UTP ((bf16_t*)(DOB + DO_UTP))
#define YF ((bf16_t*)(DOB + DO_YF))
#define YB ((bf16_t*)(DOB + DO_YB))
#define YCS ((bf16_t*)(WSB + 448 * MiB))
#define SSB ((bf16_t*)(DOB + DO_SS))

template <bool WITH_P, bool FROM_STATE, bool WITH_Y, bool STORE_E>
DI void scan_unit(LAS unsigned char* lds, const int sq, const int h, const int d, const int seg, const int nseg) {
    int tid_l = threadIdx.x; asm volatile("" : "+v"(tid_l)); const int tid = tid_l, lane = tid & 63, wave = __builtin_amdgcn_readfirstlane(tid >> 6);
    const int s0 = sq == 0 ? 0 : TPR + (sq - 1) * SL, len = sq == 0 ? TPR : SL, seglen = len / nseg, p0 = seg * seglen;
    const int u = sq * 16 + h * 2 + d;
    float* EST = (float*)(DOB + 96 * MiB); float* PST = (float*)(DOB + 128 * MiB);
    LAS float* Wd = (LAS float*)lds; LAS float* Aa = Wd + 2048; LAS float* Bb = Aa + 2048; LAS float* Kd = Bb + 2048; LAS float* Rr = Kd + 2048; LAS float* Vv = Rr + 2048;
    LAS float* WL = Vv + 2048; LAS float* AL = WL + 2048; LAS float* Yb = AL + 2048; LAS float* Sx = Yb + 2048;
    const float* w0 = getargs()->in[7] + d * 512 + h * 64; const float* w2 = getargs()->in[8] + (size_t)d * 64 * 512 + h * 64;
    const float* a0 = getargs()->in[9] + d * 512 + h * 64; const float* a2 = getargs()->in[10] + (size_t)d * 64 * 512 + h * 64;
    const float* kkp = getargs()->in[12] + h * 64; const float* kap = getargs()->in[13] + h * 64; const float* rkp = getargs()->in[14] + h * 64;
    bf16_t* YD = d ? YB : YF; float* BON = BONUS + (size_t)d * T * 8;
    const int mt = wave & 1, ntile = wave >> 1;
    bf16x8 bw[2], ba[2];
#pragma unroll
    for (int ks = 0; ks < 2; ++ks) { float fw[8], fa[8];
#pragma unroll
        for (int j = 0; j < 8; ++j) { const int k = ks * 32 + (lane >> 4) * 8 + j; fw[j] = w2[(size_t)k * 512 + ntile * 16 + (lane & 15)]; fa[j] = a2[(size_t)k * 512 + ntile * 16 + (lane & 15)]; }
        u32x4 pw = {cvtpk(fw[0], fw[1]), cvtpk(fw[2], fw[3]), cvtpk(fw[4], fw[5]), cvtpk(fw[6], fw[7])}; bw[ks] = __builtin_bit_cast(bf16x8, pw);
        u32x4 pa = {cvtpk(fa[0], fa[1]), cvtpk(fa[2], fa[3]), cvtpk(fa[4], fa[5]), cvtpk(fa[6], fa[7])}; ba[ks] = __builtin_bit_cast(bf16x8, pa); }
    const int pi = tid >> 4, pc = (tid & 15) * 4;
    const f32x4 w0v = *(const f32x4*)(w0 + pc), a0v = *(const f32x4*)(a0 + pc), kkv = *(const f32x4*)(kkp + pc), kav = *(const f32x4*)(kap + pc), rkv = *(const f32x4*)(rkp + pc);
    const int rl = lane >> 3, cgp = lane & 7, row = 8 * wave + rl;
    float st[8], sp[8];
#pragma unroll
    for (int j = 0; j < 8; ++j) { st[j] = 0.f; sp[j] = (8 * cgp + j == row) ? 1.f : 0.f; }
    if (FROM_STATE) {
        const float* e0 = EST + ((size_t)(u * 8 + 0) * 64 + row) * 64 + 8 * cgp;
#pragma unroll
        for (int j = 0; j < 8; ++j) st[j] = e0[j];
        for (int i = 1; i < seg; ++i) {
#pragma unroll
            for (int j = 0; j < 8; ++j) Sx[row * 64 + 8 * cgp + j] = st[j];
            __syncthreads();
            const float* ei = EST + ((size_t)(u * 8 + i) * 64 + row) * 64 + 8 * cgp; const float* pp = PST + (size_t)(u * 8 + i) * 4096 + 8 * cgp;
            float ac[8];
#pragma unroll
            for (int j = 0; j < 8; ++j) ac[j] = ei[j];
            for (int k = 0; k < 64; ++k) { const float sk = Sx[row * 64 + k]; const f32x4 q0 = *(const f32x4*)(pp + k * 64), q1 = *(const f32x4*)(pp + k * 64 + 4);
#pragma unroll
                for (int j = 0; j < 4; ++j) { ac[j] += sk * q0[j]; ac[4 + j] += sk * q1[j]; } }
#pragma unroll
            for (int j = 0; j < 8; ++j) st[j] = ac[j];
            __syncthreads();
        }
    }
    f32x2 st2[4], sp2[4];
#pragma unroll
    for (int j = 0; j < 4; ++j) { st2[j] = (f32x2){st[2 * j], st[2 * j + 1]}; sp2[j] = (f32x2){sp[2 * j], sp[2 * j + 1]}; }
    const int nch = seglen / 32;
    u32x2 pr, pk_, pv; bf16x8 fa_w[2], fa_a[2];
#define SCAN_TOK(c, i) (d ? (s0 + len - 1 - (p0 + (c) * 32 + (i))) : (s0 + p0 + (c) * 32 + (i)))
#define SCAN_LOAD(c) do { const int t_ = SCAN_TOK(c, pi); const bf16_t* rp = RKV + (size_t)t_ * 1536 + h * 64 + pc; \
    pr = *(const u32x2*)rp; pk_ = *(const u32x2*)(rp + 512); pv = *(const u32x2*)(rp + 1024); \
    const int ta_ = SCAN_TOK(c, mt * 16 + (lane & 15)); const bf16_t* lp = LDB + (size_t)ta_ * 384 + d * 64 + (lane >> 4) * 8; \
    fa_w[0] = *(const bf16x8*)lp; fa_w[1] = *(const bf16x8*)(lp + 32); fa_a[0] = *(const bf16x8*)(lp + 128); fa_a[1] = *(const bf16x8*)(lp + 160); } while (0)
    SCAN_LOAD(0);
    for (int c = 0; c < nch; ++c) {
        { f32x4 cw_ = {0.f, 0.f, 0.f, 0.f}, ca_ = {0.f, 0.f, 0.f, 0.f};
          cw_ = __builtin_amdgcn_mfma_f32_16x16x32_bf16(fa_w[0], bw[0], cw_, 0, 0, 0); cw_ = __builtin_amdgcn_mfma_f32_16x16x32_bf16(fa_w[1], bw[1], cw_, 0, 0, 0);
          ca_ = __builtin_amdgcn_mfma_f32_16x16x32_bf16(fa_a[0], ba[0], ca_, 0, 0, 0); ca_ = __builtin_amdgcn_mfma_f32_16x16x32_bf16(fa_a[1], ba[1], ca_, 0, 0, 0);
#pragma unroll
          for (int j = 0; j < 4; ++j) { const int rr = mt * 16 + (lane >> 4) * 4 + j, cc = ntile * 16 + (lane & 15); WL[rr * 64 + cc] = cw_[j]; AL[rr * 64 + cc] = ca_[j]; } }
        __syncthreads();
        f32x4 r4, v4, kd4, a4, b4;
        { const f32x4 wl = *(const LAS f32x4*)(WL + pi * 64 + pc), al = *(const LAS f32x4*)(AL + pi * 64 + pc);
          r4 = (f32x4){bflo(pr.x), bfhi(pr.x), bflo(pr.y), bfhi(pr.y)}; const f32x4 k4 = {bflo(pk_.x), bfhi(pk_.x), bflo(pk_.y), bfhi(pk_.y)}; v4 = (f32x4){bflo(pv.x), bfhi(pv.x), bflo(pv.y), bfhi(pv.y)};
          f32x4 lw, ic, kk4;
          float ss = 0.f, bp = 0.f;
#pragma unroll
          for (int e = 0; e < 4; ++e) { const float sg = sigmoidf_(w0v[e] + wl[e]); lw[e] = -0.6065306597126334f * sg; ic[e] = sigmoidf_(a0v[e] + al[e]);
              kk4[e] = k4[e] * kkv[e]; ss += kk4[e] * kk4[e]; kd4[e] = k4[e] * (1.f + (ic[e] - 1.f) * kav[e]); bp += r4[e] * kd4[e] * rkv[e]; }
          ss = red16(ss); bp = red16(bp);
          const float inv = 1.f / fmaxf(sqrtf(ss), 1e-12f);
#pragma unroll
          for (int e = 0; e < 4; ++e) { const float kn = kk4[e] * inv; a4[e] = -kn; b4[e] = kn * ic[e]; }
          *(LAS f32x4*)(Wd + pi * 64 + pc) = lw;
          if ((tid & 15) == 0) BON[(size_t)SCAN_TOK(c, pi) * 8 + h] = bp; }
        __syncthreads();
        if (tid < 64) { float vals[32];
#pragma unroll
            for (int t = 0; t < 32; ++t) vals[t] = Wd[t * 64 + tid];
            float acc_ = 0.f;
#pragma unroll
            for (int t = 0; t < 32; ++t) { acc_ += vals[t]; Wd[t * 64 + tid] = acc_; } }
        __syncthreads();
        { const f32x4 Lt = *(const LAS f32x4*)(Wd + pi * 64 + pc); f32x4 Lp = {0.f, 0.f, 0.f, 0.f}; if (pi > 0) Lp = *(const LAS f32x4*)(Wd + (pi - 1) * 64 + pc);
          f32x4 at, bt, kt, rt, et;
#pragma unroll
          for (int e = 0; e < 4; ++e) { const float ep = __expf(Lp[e]); et[e] = __expf(Lt[e]); const float eti = __builtin_amdgcn_rcpf(et[e]);
              at[e] = a4[e] * ep; bt[e] = b4[e] * eti; kt[e] = kd4[e] * eti; rt[e] = r4[e] * et[e]; }
          *(LAS f32x4*)(Aa + pi * 64 + pc) = at; *(LAS f32x4*)(Bb + pi * 64 + pc) = bt;
          *(LAS f32x4*)(Kd + pi * 64 + pc) = kt; *(LAS f32x4*)(Rr + pi * 64 + pc) = rt; *(LAS f32x4*)(Vv + pi * 64 + pc) = v4;
          if (pi == 31) *(LAS f32x4*)(Sx + pc) = et; }
        __syncthreads();
        if (c + 1 < nch) SCAN_LOAD(c + 1);
        float ykq = 0.f;
#define LO2(v) __builtin_shufflevector(v, v, 0, 1)
#define HI2(v) __builtin_shufflevector(v, v, 2, 3)
#define RED3(x, z) do { x += DPPF(x, 0xB1); z += DPPF(z, 0xB1); x += DPPF(x, 0x4E); z += DPPF(z, 0x4E); x += DPPF(x, 0x141); z += DPPF(z, 0x141); } while (0)
#pragma unroll 1
        for (int q = 0; q < 16; ++q) {
            f32x2 a2_[2][4], b2_[2][4], k2_[2][4], r2_[2][4]; float vvs[2];
#pragma unroll
            for (int ii = 0; ii < 2; ++ii) { const int i = 2 * q + ii;
                const f32x4 a_0 = *(const LAS f32x4*)(Aa + i * 64 + 8 * cgp), a_1 = *(const LAS f32x4*)(Aa + i * 64 + 8 * cgp + 4);
                const f32x4 b_0 = *(const LAS f32x4*)(Bb + i * 64 + 8 * cgp), b_1 = *(const LAS f32x4*)(Bb + i * 64 + 8 * cgp + 4);
                const f32x4 k_0 = *(const LAS f32x4*)(Kd + i * 64 + 8 * cgp), k_1 = *(const LAS f32x4*)(Kd + i * 64 + 8 * cgp + 4);
                const f32x4 r_0 = *(const LAS f32x4*)(Rr + i * 64 + 8 * cgp), r_1 = *(const LAS f32x4*)(Rr + i * 64 + 8 * cgp + 4);
                vvs[ii] = Vv[i * 64 + row];
                a2_[ii][0] = LO2(a_0); a2_[ii][1] = HI2(a_0); a2_[ii][2] = LO2(a_1); a2_[ii][3] = HI2(a_1);
                b2_[ii][0] = LO2(b_0); b2_[ii][1] = HI2(b_0); b2_[ii][2] = LO2(b_1); b2_[ii][3] = HI2(b_1);
                k2_[ii][0] = LO2(k_0); k2_[ii][1] = HI2(k_0); k2_[ii][2] = LO2(k_1); k2_[ii][3] = HI2(k_1);
                r2_[ii][0] = LO2(r_0); r2_[ii][1] = HI2(r_0); r2_[ii][2] = LO2(r_1); r2_[ii][3] = HI2(r_1); }
            f32x2 s2 = st2[0] * a2_[0][0], p2 = sp2[0] * a2_[0][0];
#pragma unroll
            for (int j = 1; j < 4; ++j) { s2 = st2[j] * a2_[0][j] + s2; if (WITH_P) p2 = sp2[j] * a2_[0][j] + p2; }
            float sa = s2.x + s2.y, pa = p2.x + p2.y;
            RED3(sa, pa);
            { const f32x2 sab = {sa, sa}, vvb = {vvs[0], vvs[0]}, pab = {pa, pa};
#pragma unroll
              for (int j = 0; j < 4; ++j) { st2[j] = vvb * k2_[0][j] + st2[j]; st2[j] = sab * b2_[0][j] + st2[j]; if (WITH_P) sp2[j] = pab * b2_[0][j] + sp2[j]; } }
            f32x2 y2 = st2[0] * r2_[0][0]; s2 = st2[0] * a2_[1][0]; p2 = sp2[0] * a2_[1][0];
#pragma unroll
            for (int j = 1; j < 4; ++j) { if (WITH_Y) y2 = st2[j] * r2_[0][j] + y2; s2 = st2[j] * a2_[1][j] + s2; if (WITH_P) p2 = sp2[j] * a2_[1][j] + p2; }
            float y0 = y2.x + y2.y; sa = s2.x + s2.y; pa = p2.x + p2.y;
            RED3(sa, pa);
            if (WITH_Y) { y0 += DPPF(y0, 0xB1); y0 += DPPF(y0, 0x4E); y0 += DPPF(y0, 0x141); if (cgp == ((2 * q) & 7)) ykq = y0; }
            { const f32x2 sab = {sa, sa}, vvb = {vvs[1], vvs[1]}, pab = {pa, pa};
#pragma unroll
              for (int j = 0; j < 4; ++j) { st2[j] = vvb * k2_[1][j] + st2[j]; st2[j] = sab * b2_[1][j] + st2[j]; if (WITH_P) sp2[j] = pab * b2_[1][j] + sp2[j]; } }
            if (WITH_Y) { f32x2 z2 = st2[0] * r2_[1][0];
#pragma unroll
                for (int j = 1; j < 4; ++j) z2 = st2[j] * r2_[1][j] + z2;
                float y1 = z2.x + z2.y; y1 += DPPF(y1, 0xB1); y1 += DPPF(y1, 0x4E); y1 += DPPF(y1, 0x141);
                if (cgp == ((2 * q + 1) & 7)) ykq = y1;
                if ((q & 3) == 3) Yb[(8 * (q >> 2) + cgp) * 64 + row] = ykq; }
        }
        { const f32x4 we0 = *(const LAS f32x4*)(Sx + 8 * cgp), we1 = *(const LAS f32x4*)(Sx + 8 * cgp + 4);
          const f32x2 we2[4] = {LO2(we0), HI2(we0), LO2(we1), HI2(we1)};
#pragma unroll
          for (int j = 0; j < 4; ++j) { st2[j] = st2[j] * we2[j]; if (WITH_P) sp2[j] = sp2[j] * we2[j]; } }
        if (WITH_Y) {
            __syncthreads();
            { const f32x4 y4 = *(const LAS f32x4*)(Yb + pi * 64 + pc); u32x2 w; w.x = cvtpk(y4[0], y4[1]); w.y = cvtpk(y4[2], y4[3]);
              *(u32x2*)(YD + (size_t)SCAN_TOK(c, pi) * 512 + h * 64 + pc) = w; }
        }
    }
#undef SCAN_TOK
#undef SCAN_LOAD
    if (STORE_E) {
        float* eo = EST + ((size_t)(u * 8 + seg) * 64 + row) * 64 + 8 * cgp;
        *(f32x4*)eo = (f32x4){st2[0].x, st2[0].y, st2[1].x, st2[1].y}; *(f32x4*)(eo + 4) = (f32x4){st2[2].x, st2[2].y, st2[3].x, st2[3].y};
    }
    if (WITH_P) {
        float* po = PST + ((size_t)(u * 8 + seg) * 64 + row) * 64 + 8 * cgp;
        *(f32x4*)po = (f32x4){sp2[0].x, sp2[0].y, sp2[1].x, sp2[1].y}; *(f32x4*)(po + 4) = (f32x4){sp2[2].x, sp2[2].y, sp2[3].x, sp2[3].y};
    }
}

#define XB_TMO      128
#define XB_XCNT(j)  (256  + 64 * (j))
#define XB_XSUB(j)  (1280 + 64 * (j))
#define XB_XGEN(j)  (2304 + 64 * (j))
#define XB_TOP      3328
#define XB_TOPGEN   3392
#define XCD_BAR_WORDS 3456
#define XB_SPIN_CAP (1u << 23)
DI unsigned xb_ld(unsigned* p)              { return __hip_atomic_load(p, __ATOMIC_RELAXED, __HIP_MEMORY_SCOPE_AGENT); }
DI unsigned xb_add(unsigned* p, unsigned v) { return __hip_atomic_fetch_add(p, v, __ATOMIC_RELAXED, __HIP_MEMORY_SCOPE_AGENT); }
DI unsigned xb_xcc_id() { return (unsigned)__builtin_amdgcn_s_getreg((3 << 11) | 20) & 0xFu; }
#define XB_SPIN(cond, bar) do { unsigned _sp = 0; while (cond) { __builtin_amdgcn_s_sleep(1); \
    if ((++_sp & 255u) == 0u) { if (xb_ld(&(bar)[XB_TMO])) break; if (_sp > XB_SPIN_CAP) { atomicAdd(&(bar)[XB_TMO], 1u); break; } } } } while (0)
DI void xcd_barrier_complete(unsigned* bar, unsigned x, unsigned& nloc, unsigned& nx) {
    const unsigned G = gridDim.x;
    unsigned sum, cnt, mine, sp = 0u;
    for (;;) {
        sum = 0u; cnt = 0u; mine = 0u;
#pragma unroll
        for (unsigned j = 0; j < 16; ++j) { const unsigned c = xb_ld(&bar[XB_XCNT(j)]); sum += c; cnt += (c > 0u) ? 1u : 0u; mine = (j == x) ? c : mine; }
        if (sum == G) break;
        __builtin_amdgcn_s_sleep(1);
        if ((++sp & 255u) == 0u) { if (xb_ld(&bar[XB_TMO])) break; if (sp > XB_SPIN_CAP) { atomicAdd(&bar[XB_TMO], 1u); break; } }
    }
    nloc = mine > 0u ? mine : 1u; nx = cnt > 0u ? cnt : 1u;
}
DI void xcd_barrier(unsigned* bar, const unsigned x, volatile LAS unsigned* st) {
    asm volatile("s_waitcnt vmcnt(0)" ::: "memory");
    __syncthreads();
    if (threadIdx.x == 0) {
        __builtin_amdgcn_s_waitcnt(0);
        unsigned nloc = st[0], nx = st[1];
        if (nloc == 0u) { xcd_barrier_complete(bar, x, nloc, nx); st[0] = nloc; st[1] = nx; }
        const unsigned old = xb_add(&bar[XB_XSUB(x)], 1u);
        const unsigned gen = old / nloc;
        if (old + 1u == (gen + 1u) * nloc) {
            __builtin_amdgcn_fence(__ATOMIC_RELEASE, "agent");
            asm volatile("s_waitcnt vmcnt(0)" ::: "memory");
            const unsigned og = xb_add(&bar[XB_TOP], 1u);
            const unsigned tg = og / nx;
            if (og + 1u == (tg + 1u) * nx) xb_add(&bar[XB_TOPGEN], 1u);
            else XB_SPIN(xb_ld(&bar[XB_TOPGEN]) == tg, bar);
            __builtin_amdgcn_fence(__ATOMIC_ACQUIRE, "agent");
            xb_add(&bar[XB_XGEN(x)], 1u);
            asm volatile("s_waitcnt vmcnt(0)" ::: "memory");
        } else {
            XB_SPIN(xb_ld(&bar[XB_XGEN(x)]) == gen, bar);
            __builtin_amdgcn_fence(__ATOMIC_ACQUIRE, "agent");
            asm volatile("s_waitcnt vmcnt(0)" ::: "memory");
        }
    }
    __syncthreads();
}
#define GSYNC() xcd_barrier((unsigned*)(WSB + 4096), xb_xcc_id(), (volatile LAS unsigned*)(lds + LDS_BYTES - 64))
#define PHASE_IDS int tid_l = threadIdx.x; asm volatile("" : "+v"(tid_l)); const int tid = tid_l, lane = tid & 63, wave = __builtin_amdgcn_readfirstlane(tid >> 6), G = gridDim.x, bx = blockIdx.x, gw = bx * 8 + wave, NGW = G * 8, gtid = bx * 512 + tid, NTH = G * 512; (void)lane; (void)gw; (void)NGW; (void)gtid; (void)NTH; (void)wave
__global__ void __launch_bounds__(512, 2) fwd_mega(Args a_unused) {
    extern __shared__ __attribute__((aligned(16))) unsigned char lds_raw[];
    LAS unsigned char* lds = (LAS unsigned char*)lds_raw;
    cg::grid_group grid = cg::this_grid();
    if (threadIdx.x < 16) ((LAS unsigned*)(lds + LDS_BYTES - 64))[threadIdx.x] = 0u;
    __syncthreads();
    REP(0) if (PH(0)) { PHASE_IDS;
        LAS float* scr = (LAS float*)(lds + wave * 16384);
        constexpr int I0 = 16 * 64, I1 = 2 * 16, I2 = 16 * 32, I3 = 16 * 176, I4 = 44 * 32, I5 = 16 * 96, I6 = 16 * 32;
        constexpr int NITEMS = I0 + I1 + I2 + 2 * I3 + 2 * I4 + I5 + I6;
        for (int it = gw; it < NITEMS; it += NGW) {
            int r = it; const int ln = lane & 31;
            if (r < I0) { const int nblk = 64, kb = r / nblk, nb = r % nblk; const int n = 512 + nb * 32 + ln; const int src = n < MIXIN ? n : -1;
                tr_item(getargs()->in[4], MIXIN, 1024, W_IN, 512 + nb * 32, kb * 64, src, lane, scr); continue; } r -= I0;
            if (r < I1) { const int nblk = 16, kb = r / nblk, nb = r % nblk; tr_item(getargs()->in[11], 512, 128, W_G, nb * 32, kb * 64, nb * 32 + ln, lane, scr); continue; } r -= I1;
            if (r < I2) { const int nblk = 32, kb = r / nblk, nb = r % nblk; tr_item(getargs()->in[17], 1024, 1024, W_OUT0, nb * 32, kb * 64, nb * 32 + ln, lane, scr); continue; } r -= I2;
            if (r < 2 * I3) { const int l = r / I3; r -= l * I3; const int nblk = 176, kb = r / nblk, nb = r % nblk; const int n = nb * 32 + ln;
                const int src = (n >> 8) * 128 + (n & 127) + ((n >> 7) & 1) * FF;
                tr_item(getargs()->in[29] + (size_t)l * 1024 * NUP, NUP, 1024, W_UP + (size_t)l * NUP * 1024, nb * 32, kb * 64, src, lane, scr); continue; } r -= 2 * I3;
            if (r < 2 * I4) { const int l = r / I4; r -= l * I4; const int nblk = 32, kb = r / nblk, nb = r % nblk;
                tr_item(getargs()->in[32] + (size_t)l * FF * 1024, 1024, FF, W_DN + (size_t)l * 1024 * FF, nb * 32, kb * 64, nb * 32 + ln, lane, scr); continue; } r -= 2 * I4;
            if (r < I5) { const int nblk = 96, kb = r / nblk, nb = r % nblk; const int n = nb * 32 + ln; int src = n;
                if (n < 2048) { const int p = n & 63; src = (n & ~63) + 32 * ((p >> 2) & 1) + 4 * (p >> 3) + (p & 3); }
                tr_item(getargs()->in[20], 3072, 1024, W_QKV, nb * 32, kb * 64, src, lane, scr); continue; } r -= I5;
            { const int nblk = 32, kb = r / nblk, nb = r % nblk; tr_item(getargs()->in[26], 1024, 1024, W_O, nb * 32, kb * 64, nb * 32 + ln, lane, scr); }
        }
        for (int e = gtid; e < 512 * 1024; e += NTH) { const int k = e >> 9, n = e & 511, cs = n >> 8, g = (n >> 5) & 7, c2 = n & 31;
            const float* wr_ = getargs()->in[4] + (size_t)k * MIXIN + g * 64; float s = 0.f; const int cf = (cs && c2 == 0) ? 32 : c2; const bool use_sin = cs && c2 != 0;
            for (int c = 0; c < 64; ++c) { const float ph = (float)((c * cf) & 63) * (1.f / 64.f); s += wr_[c] * (use_sin ? __builtin_amdgcn_sinf(ph) : __builtin_amdgcn_cosf(ph)); }
            W_IN[(size_t)n * 1024 + k] = f2bf(s); }
        for (int e = gtid; e < 4608 * 512; e += NTH) { const int row = e >> 9, j0 = (e & 511) * 8; const int kp = row < 2304 ? row : row - 2304; float v[8];
#pragma unroll
            for (int jj = 0; jj < 8; ++jj) { const float ph = (float)((kp * (j0 + jj)) & 4095) * (1.f / 4096.f); v[jj] = row < 2304 ? __builtin_amdgcn_cosf(ph) : __builtin_amdgcn_sinf(ph); }
            u32x4 w; w.x = cvtpk(v[0], v[1]); w.y = cvtpk(v[2], v[3]); w.z = cvtpk(v[4], v[5]); w.w = cvtpk(v[6], v[7]);
            *(u32x4*)(DFTM + (size_t)row * 4096 + j0) = w; }
        for (int e = gtid; e < TPR * 32; e += NTH) { const int pos = e >> 5, i = e & 31; const float invf = exp2f(-(float)i * (13.287712379549449f / 32.f));
            double rev = (double)pos * (double)invf * 0.15915494309189535; rev -= floor(rev); const float fr_ = (float)rev;
            ROPEC[e] = __builtin_amdgcn_cosf(fr_); ROPES[e] = __builtin_amdgcn_sinf(fr_); }
        if (bx == 0) for (int w_ = tid; w_ < XCD_BAR_WORDS; w_ += 512) ((unsigned*)(WSB + 4096))[w_] = 0u;
        for (int m = gw; m < T; m += 2 * NGW) row_item2(xin_row(x_prompt, x_sample, m), xin_row(x_prompt, x_sample, m + NGW), nullptr, nullptr, nullptr, nullptr, nullptr, getargs()->in[2], HN + (size_t)m * DM, HN + (size_t)(m + NGW) * DM, lane);
    }
    grid.sync();
    if (threadIdx.x == 0) (void)xb_add(&((unsigned*)(WSB + 4096))[XB_XCNT(xb_xcc_id())], 1u);

#ifdef EXTRASYNC
    for (int es_ = 0; es_ < 20; ++es_) GSYNC();
#endif
    REP(1) if (PH(1)) { PHASE_IDS;
        pg8::Gemm g{HN - DM, W_IN, 1024, 1024, 1024};
        pg8::Sched S; S.init(199, 10, G, bx, (size_t)248 * 2048, (size_t)256 * 2048, 1 << 20, 0);
        pg8::EpiIn E{getargs()->in[5], getargs()->in[6], UTS, UTP, RKV, LDB};
        pg8::gemm_phase<pg8::EpiIn, 1>(lds, g, S, E);
    }
    GSYNC();

    REP(2) if (PH(2)) { PHASE_IDS;
#pragma unroll 1
        for (int gi = 0; gi < 2; ++gi) {
            const bf16_t* Ap = gi == 1 ? (const bf16_t*)(LDB + 256) : (const bf16_t*)DFTM;
            const bf16_t* Bp = gi == 0 ? (const bf16_t*)UTS : (const bf16_t*)W_G;
            const int Kk = gi == 1 ? 128 : 4096, lda = gi == 1 ? 384 : 4096, ldb = Kk;
            const int nM = gi == 1 ? 192 : 216, nN = 2, tpb = gi == 1 ? (1 << 20) : 18;
            const size_t bb = gi == 1 ? 0 : (size_t)512 * 4096 * 2;
            bf16_t* Op = gi == 0 ? YCS : GATE; const int ldc = 512;
            pg8::Gemm g{Ap, Bp, Kk, lda, ldb}; pg8::Sched S; S.init(nM, nN, G, bx, (size_t)256 * lda * 2, (size_t)256 * ldb * 2, tpb, bb);
            pg8::EpiStore E{Op, ldc, 0, 1.f}; pg8::gemm_phase<pg8::EpiStore, 0>(lds, g, S, E);
        }
    }
    GSYNC();

    REP(3) if (PH(3)) {
        if (blockIdx.x < 240) { int sq, h, d, seg, nseg; const int b_ = blockIdx.x;
            if (b_ < 112) { const int hd = b_ / 7; seg = b_ % 7; sq = 0; h = hd >> 1; d = hd & 1; nseg = 8; }
            else { const int v = b_ - 112; sq = 1 + (v >> 4); h = (v >> 1) & 7; d = v & 1; seg = 0; nseg = 2; }
            if (seg == 0) scan_unit<false, false, true, true>(lds, sq, h, d, seg, nseg); else scan_unit<true, false, false, true>(lds, sq, h, d, seg, nseg); }
        GSYNC();
        if (blockIdx.x < 240) { int sq, h, d, seg, nseg; const int b_ = blockIdx.x;
            if (b_ < 112) { const int hd = b_ / 7; seg = 1 + b_ % 7; sq = 0; h = hd >> 1; d = hd & 1; nseg = 8; }
            else { const int v = b_ - 112; sq = 1 + (v >> 4); h = (v >> 1) & 7; d = v & 1; seg = 1; nseg = 2; }
            scan_unit<false, true, true, false>(lds, sq, h, d, seg, nseg); }
    }
    GSYNC();

    if (PH(4)) { PHASE_IDS;
        { const int c = gtid & 511, g = c >> 6, cc = c & 63;
          const bool mtok = cc > 32; const int ch = mtok ? 64 - cc : cc;
          const float hs = ((ch != 0) && (ch != 32)) ? 1.f : 0.f;
          const int colU = (ch == 32) ? 256 + g * 32 : g * 32 + ch, colS = 256 + g * 32 + ch;
          for (int it0 = gtid; it0 < TPR * 512; it0 += 4 * NTH) {
              unsigned short vcu[4][4], vsu[4][4], vcs[4][4], vss[4][4]; float sKv[4]; int s2pv[4];
#pragma unroll
              for (int q = 0; q < 4; ++q) { const int sp = (it0 + q * NTH) >> 9; const int s2p = mtok ? ((TPR - sp) & (TPR - 1)) : sp; s2pv[q] = s2p;
                  const int k = s2p & 4095; const bool mir = k > 2048; const int kp = mir ? 4096 - k : k; sKv[q] = mir ? -1.f : 1.f;
#pragma unroll
                  for (int s2 = 0; s2 < 4; ++s2) { const bf16_t* bc = YCS + ((size_t)(s2 * 4608 + kp)) * 512; const bf16_t* bs = bc + (size_t)2304 * 512;
                      vcu[q][s2] = bc[colU]; vsu[q][s2] = bs[colU]; vcs[q][s2] = bc[colS]; vss[q][s2] = bs[colS]; } }
#pragma unroll
              for (int q = 0; q < 4; ++q) { const int sp = (it0 + q * NTH) >> 9; float accv = 0.f;
#pragma unroll
                  for (int s2 = 0; s2 < 4; ++s2) { const float ph = (float)((s2 * s2pv[q]) & 16383) * (1.f / 16384.f); const float cph = __builtin_amdgcn_cosf(ph), sph = __builtin_amdgcn_sinf(ph);
                      const float CU = bf2f(vcu[q][s2]), SUc = bf2f(vsu[q][s2]), CUs = hs * bf2f(vcs[q][s2]), SUs = hs * bf2f(vss[q][s2]);
                      accv += cph * (CU - sKv[q] * SUs) + sph * (-CUs - sKv[q] * SUc); }
                  HN[(size_t)sp * DM + c] = f2bf(accv * (1.f / 1024.f)); } }
          for (int it0 = TPR * 512 + gtid; it0 < T * 512; it0 += 8 * NTH) {
              unsigned short vcu[8], vss[8]; float sKv[8];
#pragma unroll
              for (int q = 0; q < 8; ++q) { const int sp = (it0 + q * NTH) >> 9; const int sq = (sp - TPR) >> 12, s1 = sp & 4095; const int k = mtok ? ((SL - s1) & (SL - 1)) : s1;
                  const bool mir = k > 2048; const int kp = mir ? 4096 - k : k; sKv[q] = mir ? -1.f : 1.f;
                  const bf16_t* bc = YCS + ((size_t)((4 + sq) * 4608 + kp)) * 512; vcu[q] = bc[colU]; vss[q] = bc[(size_t)2304 * 512 + colS]; }
#pragma unroll
              for (int q = 0; q < 8; ++q) { const int sp = (it0 + q * NTH) >> 9;
                  HN[(size_t)sp * DM + c] = f2bf((bf2f(vcu[q]) - sKv[q] * hs * bf2f(vss[q])) * (1.f / 512.f)); } }
        }
        for (int it0 = gtid; it0 < T * 8 * 16; it0 += 4 * NTH) { const int h = (it0 >> 4) & 7, c = h * 64 + (it0 & 15) * 4;
            u32x2 yf[4], yb[4], vv[4], gg[4]; float bon[4];
#pragma unroll
            for (int q = 0; q < 4; ++q) { const int t = (it0 + q * NTH) >> 7;
                yf[q] = *(const u32x2*)(YF + (size_t)t * 512 + c); yb[q] = *(const u32x2*)(YB + (size_t)t * 512 + c);
                vv[q] = *(const u32x2*)(RKV + (size_t)t * 1536 + 1024 + c); gg[q] = *(const u32x2*)(GATE + (size_t)t * 512 + c);
                bon[q] = BONUS[(size_t)t * 8 + h] + BONUS[(size_t)T * 8 + (size_t)t * 8 + h]; }
            const f32x4 lg = *(const f32x4*)(getargs()->in[15] + c), lb = *(const f32x4*)(getargs()->in[16] + c);
#pragma unroll
            for (int q = 0; q < 4; ++q) { const int t = (it0 + q * NTH) >> 7;
                f32x4 y = {bflo(yf[q].x) + bflo(yb[q].x), bfhi(yf[q].x) + bfhi(yb[q].x), bflo(yf[q].y) + bflo(yb[q].y), bfhi(yf[q].y) + bfhi(yb[q].y)};
                const float mu = red16((y[0] + y[1]) + (y[2] + y[3])) * (1.f / 64.f);
                y = y - mu; const float var = red16((y[0] * y[0] + y[1] * y[1]) + (y[2] * y[2] + y[3] * y[3])) * (1.f / 64.f);
                const float rs = rsqrtf(var + 64e-5f);
                const f32x4 v4 = {bflo(vv[q].x), bfhi(vv[q].x), bflo(vv[q].y), bfhi(vv[q].y)}, g4 = {bflo(gg[q].x), bfhi(gg[q].x), bflo(gg[q].y), bfhi(gg[q].y)};
                const f32x4 o = (y * rs * lg + lb + bon[q] * v4) * g4;
                u32x2 w; w.x = cvtpk(o[0], o[1]); w.y = cvtpk(o[2], o[3]);
                *(u32x2*)(HN + (size_t)t * DM + 512 + c) = w; } }
    }
    GSYNC();

    if (PH(5)) { PHASE_IDS;
        pg8::Gemm g{HN, W_OUT0, 1024, 1024, 1024}; pg8::Sched S; S.init(192, 4, G, bx, (size_t)256 * 2048, (size_t)256 * 2048, 1 << 20, 0);
        pg8::EpiStore E{RAWB, 1024, 0, 1.f}; pg8::gemm_phase<pg8::EpiStore, 0>(lds, g, S, E);
    }
    GSYNC();
    { PHASE_IDS; for (int m = gw; m < T; m += 2 * NGW) row_item2(xin_row(x_prompt, x_sample, m), xin_row(x_prompt, x_sample, m + NGW), RAWB + (size_t)m * DM, RAWB + (size_t)(m + NGW) * DM, getargs()->in[3], getargs()->out + (size_t)m * DM, getargs()->out + (size_t)(m + NGW) * DM, getargs()->in[27], HN + (size_t)m * DM, HN + (size_t)(m + NGW) * DM, lane); }
    GSYNC();

#pragma unroll 1
    for (int layer = 0; layer < 2; ++layer) {
        if (layer == 1) {
            REP(10) if (PH(10)) { PHASE_IDS; pg8::Gemm g{HN, W_QKV, 1024, 1024, 1024}; pg8::Sched S; S.init(192, 12, G, bx, (size_t)256 * 2048, (size_t)256 * 2048, 1 << 20, 0);
              pg8::EpiQkv E{ROPEC, ROPES, QB}; pg8::gemm_phase<pg8::EpiQkv, 0>(lds, g, S, E); }
            GSYNC();
            REP(11) if (PH(11)) {
                char* alds = (char*)lds_raw;
                for (int un = blockIdx.x; un < 1536; un += gridDim.x) {
                    int qrow0, h, kv0, seq;
                    if (un < 512) { h = un & 7; qrow0 = (un >> 3) * 256; kv0 = 0; seq = TPR; }
                    else { const int v = un - 512; h = v & 7; const int qb = v >> 3; qrow0 = TPR + qb * 256; kv0 = TPR + (qb >> 4) * SL; seq = SL; }
#pragma unroll 1
                    for (int c = 0; c < 2; ++c) {
                        f32x16 o[4]; float l_reg;
                        __syncthreads();
                        att::attn_pass(QB + (size_t)qrow0 * 1024 + h * 128 + c * 64, KB + (size_t)kv0 * 1024 + h * 128 + c * 64, VB + (size_t)kv0 * 1024 + h * 128, seq, alds, o, l_reg);
                        int tid2 = threadIdx.x; asm volatile("" : "+v"(tid2));
                        const int tidq = tid2, laneq = tidq & 63, r32 = laneq & 31, hi = laneq >> 5;
                        float* wsl = (float*)(alds + 2 * att::SHM_V + 2 * att::SHM_K) + (tidq >> 6) * 64;
                        float* tmp = (float*)(WSB + WS_ATMP) + (size_t)blockIdx.x * (64 * 512);
                        if (hi == 0) wsl[r32] = l_reg; asm volatile("s_waitcnt lgkmcnt(0)" ::: "memory");
                        float rli[16];
#pragma unroll
                        for (int r = 0; r < 16; ++r) rli[r] = __builtin_amdgcn_rcpf(wsl[att::crow(r, hi)]);
                        if (c == 0) {
#pragma unroll
                            for (int d0 = 0; d0 < 4; ++d0) { float* tp = tmp + d0 * 8192 + tidq;
#pragma unroll
                                for (int r = 0; r < 16; ++r) tp[r * 512] = o[d0][r] * rli[r];
                                __builtin_amdgcn_sched_barrier(0); }
                        } else {
                            const float l1 = wave_sum(getargs()->in[21][laneq] * getargs()->in[22][laneq]), l2 = wave_sum(getargs()->in[23][laneq] * getargs()->in[24][laneq]);
                            const float lam = __expf(l1) - __expf(l2) + LAMBDA_INIT;
                            float ssq[16];
#pragma unroll
                            for (int r = 0; r < 16; ++r) ssq[r] = 0.f;
#pragma unroll
                            for (int d0 = 0; d0 < 4; ++d0) { const float* tp = tmp + d0 * 8192 + tidq;
#pragma unroll
                                for (int r = 0; r < 16; ++r) { const float v = tp[r * 512] - lam * (o[d0][r] * rli[r]); o[d0][r] = v; ssq[r] += v * v; }
                                __builtin_amdgcn_sched_barrier(0); }
#pragma unroll
                            for (int r = 0; r < 16; ++r) { float s = ssq[r]; s += __shfl_xor(s, 1); s += __shfl_xor(s, 2); s += __shfl_xor(s, 4); s += __shfl_xor(s, 8); s += __shfl_xor(s, 16);
                                ssq[r] = rsqrtf(s * (1.f / 128.f) + 1e-5f) * (1.f - LAMBDA_INIT); }
                            bf16_t* Ow = HN + (size_t)(qrow0 + (tidq >> 6) * 32) * DM + h * 128;
#pragma unroll
                            for (int d0 = 0; d0 < 4; ++d0) { const float gsub = getargs()->in[25][d0 * 32 + r32]; bf16_t* op = Ow + (size_t)(4 * hi) * DM + d0 * 32 + r32;
#pragma unroll
                                for (int r = 0; r < 16; ++r) op[((r & 3) + 8 * (r >> 2)) * DM] = f2bf(o[d0][r] * ssq[r] * gsub);
                                __builtin_amdgcn_sched_barrier(0); }
                        }
                    }
                }
                __syncthreads();
            }
            GSYNC();
            if (PH(12)) { PHASE_IDS; pg8::Gemm g{HN, W_O, 1024, 1024, 1024}; pg8::Sched S; S.init(192, 4, G, bx, (size_t)256 * 2048, (size_t)256 * 2048, 1 << 20, 0);
              pg8::EpiStore E{RAWB, 1024, 0, 1.f}; pg8::gemm_phase<pg8::EpiStore, 0>(lds, g, S, E); }
            GSYNC();
            { PHASE_IDS; for (int m = gw; m < T; m += 2 * NGW) row_item2(getargs()->out + (size_t)m * DM, getargs()->out + (size_t)(m + NGW) * DM, RAWB + (size_t)m * DM, RAWB + (size_t)(m + NGW) * DM, getargs()->in[19], getargs()->out + (size_t)m * DM, getargs()->out + (size_t)(m + NGW) * DM, getargs()->in[27] + DM, HN + (size_t)m * DM, HN + (size_t)(m + NGW) * DM, lane); }
            GSYNC();
        }
        REP(7) if (PH(7)) { PHASE_IDS; pg8::Gemm g{HN - DM, W_UP + (size_t)layer * NUP * 1024, 1024, 1024, 1024}; pg8::Sched S; S.init(199, 22, G, bx, (size_t)248 * 2048, (size_t)256 * 2048, 1 << 20, 0);
          pg8::EpiUp E{getargs()->in[30] + (size_t)layer * 3 * NUP, getargs()->in[31] + (size_t)layer * NUP, ACT}; pg8::gemm_phase<pg8::EpiUp, 1>(lds, g, S, E); }
        GSYNC();
        REP(8) if (PH(8)) { PHASE_IDS; pg8::Gemm g{ACT, W_DN + (size_t)layer * 1024 * FF, FF, FF, FF}; pg8::Sched S; S.init(192, 4, G, bx, (size_t)256 * FF * 2, (size_t)256 * FF * 2, 1 << 20, 0);
          pg8::EpiStore E{HN, 1024, 0, 1.f}; pg8::gemm_phase<pg8::EpiStore, 0>(lds, g, S, E); }
        GSYNC();
        { PHASE_IDS; for (int m = gw; m < T; m += 2 * NGW) row_item2(getargs()->out + (size_t)m * DM, getargs()->out + (size_t)(m + NGW) * DM, HN + (size_t)m * DM, HN + (size_t)(m + NGW) * DM, getargs()->in[28] + layer * DM, getargs()->out + (size_t)m * DM, getargs()->out + (size_t)(m + NGW) * DM, layer == 0 ? getargs()->in[18] : nullptr, HN + (size_t)m * DM, HN + (size_t)(m + NGW) * DM, lane); }
        if (layer == 0) GSYNC();
    }
}

extern "C" void kernel_launch(void* const* d_in, const int* in_sizes, int n_in, void* d_out, int out_size, void* d_ws, size_t ws_size, hipStream_t stream) {
    static int grid = 0;
    if (grid == 0) {
        if (n_in != 33 || out_size != T * DM || ws_size < WS_END) { fprintf(stderr, "kernel_launch: unexpected shapes: n_in %d out %d ws %zu (need %zu)\n", n_in, out_size, ws_size, (size_t)WS_END); grid = -1; return; }
        int dev = 0, cus = 0, per_cu = 0;
        hipGetDevice(&dev); hipDeviceGetAttribute(&cus, hipDeviceAttributeMultiprocessorCount, dev);
        if (hipFuncSetAttribute((const void*)fwd_mega, hipFuncAttributeMaxDynamicSharedMemorySize, LDS_BYTES) != hipSuccess) { fprintf(stderr, "kernel_launch: hipFuncSetAttribute failed\n"); grid = -1; return; }
        hipOccupancyMaxActiveBlocksPerMultiprocessor(&per_cu, (const void*)fwd_mega, 512, LDS_BYTES);
        (void)hipGetLastError();
        if (per_cu < 1) per_cu = 1;
        grid = cus;
        if (grid > NBLK) grid = NBLK;
    }
    if (grid < 0) return;
    Args a{};
    for (int i = 0; i < 33; ++i) a.in[i] = (const float*)d_in[i];
    a.out = (float*)d_out; a.ws = (unsigned char*)d_ws;
    void* args[] = {&a};
    hipError_t e = hipLaunchCooperativeKernel((const void*)fwd_mega, dim3(grid), dim3(512), args, LDS_BYTES, stream);
    if (e != hipSuccess) fprintf(stderr, "kernel_launch: cooperative launch failed: %s (grid %d)\n", hipGetErrorString(e), grid);
}
```

```cpp
#include <hip/hip_runtime.h>
#include <hip/hip_cooperative_groups.h>
#include <cstdio>
#include <cstdint>
namespace cg = cooperative_groups;

#define DI __device__ __forceinline__
#define LAS __attribute__((address_space(3)))
typedef unsigned short bf16_t;
typedef short bf16x8 __attribute__((ext_vector_type(8)));
typedef short s16x4 __attribute__((ext_vector_type(4)));
typedef float f32x2 __attribute__((ext_vector_type(2)));
typedef float f32x4 __attribute__((ext_vector_type(4)));
typedef float f32x16 __attribute__((ext_vector_type(16)));
typedef unsigned u32x2 __attribute__((ext_vector_type(2)));
typedef unsigned u32x4 __attribute__((ext_vector_type(4)));

constexpr int T = 49152, DM = 1024, TPR = 16384, SL = 4096;
constexpr int NIN = 2560;
constexpr int ZR = 1920, MIXIN = 2432;
constexpr int FF = 2816, NUP = 5632;
constexpr int NBLK = 256;
constexpr float LAMBDA_INIT = 0.35550906759f;

constexpr size_t MiB = 1u << 20;
constexpr size_t WS_WIN = 1 * MiB, WS_WG = 7 * MiB, WS_WOUT0 = 8 * MiB, WS_WUP = 10 * MiB, WS_WDN = 32 * MiB, WS_WQKV = 43 * MiB, WS_WO = 49 * MiB;
constexpr size_t WS_ROPE = 51 * MiB, WS_BONUS = 55 * MiB, WS_DFT = 58 * MiB, WS_HNRAW = 122 * MiB, WS_B = 220 * MiB, WS_END = 512 * MiB;
constexpr size_t WS_HN = WS_HNRAW + 256 * 2048;
constexpr size_t WS_RKV = WS_B, WS_LD = WS_B + 144 * MiB, WS_GATE = WS_B + 180 * MiB, WS_YC = WS_B + 228 * MiB;
constexpr size_t WS_RAWB = WS_B, WS_ACT = WS_B, WS_Q = WS_B, WS_K = WS_B + 96 * MiB, WS_V = WS_B + 192 * MiB;
constexpr size_t WS_ATMP = WS_DFT;
constexpr size_t DO_UTS = 0, DO_UTP = 64 * MiB, DO_YF = 0, DO_YB = 48 * MiB, DO_SC = 146 * MiB, DO_SS = 166 * MiB;

constexpr int LDS_BYTES = 147456;
#ifndef PHMASK
#define PHMASK 0xFFFF
#endif
#define PH(k) ((PHMASK >> (k)) & 1)
#ifndef DUPMASK
#define DUPMASK 0
#endif
#define REP(k) for (int rep_ = 0; rep_ < 1 + ((DUPMASK >> (k)) & 1); ++rep_)

struct Args { const float* in[33]; float* out; unsigned char* ws; };

DI unsigned cvtpk(float lo, float hi) { unsigned r; asm volatile("v_cvt_pk_bf16_f32 %0, %1, %2" : "=v"(r) : "v"(lo), "v"(hi)); return r; }
DI unsigned short f2bf(float f) { return (unsigned short)(cvtpk(f, f) & 0xffffu); }
DI float bf2f(unsigned h) { return __uint_as_float(h << 16); }
DI float bflo(unsigned w) { return __uint_as_float(w << 16); }
DI float bfhi(unsigned w) { return __uint_as_float(w & 0xffff0000u); }
DI float dppf(float v, const int ctrl) { return v; }
#define DPPF(v, ctrl) __builtin_bit_cast(float, __builtin_amdgcn_update_dpp(0, __builtin_bit_cast(int, (v)), (ctrl), 0xf, 0xf, true))
DI float red8(float v) { v += DPPF(v, 0xB1); v += DPPF(v, 0x4E); v += DPPF(v, 0x141); return v; }
DI float red16(float v) { v = red8(v); v += DPPF(v, 0x128); return v; }
DI float wave_sum(float v) {
#pragma unroll
    for (int o = 1; o < 64; o <<= 1) v += __shfl_xor(v, o);
    return v;
}
DI float sigmoidf_(float x) { return __builtin_amdgcn_rcpf(1.f + __expf(-x)); }
DI bool is_first(int t) { return t == 0 || (t >= TPR && (t & (SL - 1)) == 0); }
DI bool is_last(int t) { return t == TPR - 1 || (t >= TPR && (t & (SL - 1)) == SL - 1); }
DI int seq_pos(int t) { return t < TPR ? t : (t & (SL - 1)); }
DI const float* xin_row(const float* xp, const float* xs, int t) { return t < TPR ? xp + (size_t)t * DM : xs + (size_t)(t - TPR) * DM; }

namespace pg8 {
constexpr int BM = 256, BK = 64, HALF = 128, HTB = HALF * BK * 2, NXCD = 8, WGM = 8;
DI int lds_byte(int r, int c) { const int st = (r >> 4) * 2 + (c >> 5), rr = r & 15, cc = c & 31, ob = rr * 64 + cc * 2; return st * 1024 + (ob ^ (((ob >> 9) & 1) << 5)); }
DI void stage_rc(int b, int& R, int& C) { const int st = b / 1024, sb = b % 1024, swz = sb ^ (((sb >> 9) & 1) << 5); R = (st >> 1) * 16 + swz / 64; C = (st & 1) * 32 + (swz % 64) / 2; }
DI int perm32(int rho) { const int n = rho >> 4, i = rho & 15; return 8 * (i >> 2) + 4 * n + (i & 3); }

struct Unit { int pm, pn; };
struct Gemm { const bf16_t* A; const bf16_t* Bt; int K, lda, ldb; };

struct Sched {
    int nM, nN, nwg, G, c, tpb; size_t a_tstep, b_tstep, b_batch;
    DI void init(int nM_, int nN_, int G_, int c_, size_t a_tstep_, size_t b_tstep_, int tpb_, size_t b_batch_) {
        nM = nM_; nN = nN_; nwg = nM * nN; G = G_; c = c_; a_tstep = a_tstep_; b_tstep = b_tstep_; tpb = tpb_; b_batch = b_batch_; }
    DI bool next(int i, Unit& u) const {
        const long L = (long)i * G + c; if (L >= nwg) return false;
        int wgid = (int)L; { const int q = nwg / NXCD, r = nwg % NXCD, xcd = wgid % NXCD, off = wgid / NXCD; wgid = (xcd < r ? xcd * (q + 1) : r * (q + 1) + (xcd - r) * q) + off; }
        const int nig = WGM * nN, gid = wgid / nig, fm = gid * WGM, gsz = (nM - fm) < WGM ? (nM - fm) : WGM;
        u.pm = fm + ((wgid % nig) % gsz); u.pn = (wgid % nig) / gsz; return true;
    }
    DI size_t aoff(const Unit& u) const { return (size_t)(u.pm % tpb) * a_tstep; }
    DI size_t boff(const Unit& u) const { return (size_t)(u.pm / tpb) * b_batch + (size_t)u.pn * b_tstep; }
};

template <class Epi, int OVL>
DI void gemm_phase(LAS unsigned char* lds, const Gemm g, const Sched& S, const Epi& E) {
    int tid_ = threadIdx.x; asm volatile("" : "+v"(tid_));
    const int tid = tid_, wid = __builtin_amdgcn_readfirstlane(tid >> 6), lane = tid & 63, wr = wid >> 2, wc = wid & 3, fr = lane & 15, fq = lane >> 4;
    const int K = g.K, nt = K / BK;
    unsigned voffA[2], voffB[2];
#pragma unroll
    for (int i = 0; i < 2; ++i) { int R, C; stage_rc(tid * 16 + i * 8192, R, C); const int Rb = (R & ~31) + perm32(R & 31);
        const int Ra = OVL ? ((R >> 6) * 62 + (R & 63)) : R;
        voffA[i] = (unsigned)(Ra * g.lda + C) * 2u; voffB[i] = (unsigned)(Rb * g.ldb + C) * 2u; }
    const size_t kstep = (size_t)(BK * 2);
    const size_t hstepA = (size_t)(OVL ? 124 : 128) * g.lda * 2, hstepB = (size_t)HALF * g.ldb * 2;
    const unsigned ldsw = (unsigned)wid * 1024u;
    const int aoff = lds_byte(wr * 64 + fr, fq * 8), boff = lds_byte(wc * 32 + fr, fq * 8);
#define PG8_SA(b, h) (((b) * 2 + (h)) * HTB)
#define PG8_SB(b, h) ((4 + (b) * 2 + (h)) * HTB)
#define PG8_STAGE(bufoff, gbase, voff) do { _Pragma("unroll") for (int _i = 0; _i < 2; ++_i) \
        __builtin_amdgcn_global_load_lds((const unsigned*)((const char*)(gbase) + (voff)[_i]), (LAS unsigned*)(lds + (bufoff) + ldsw + _i * 8192), 16, 0, 0); } while (0)
#define PG8_LDA(dst, b, h) do { _Pragma("unroll") for (int m = 0; m < 4; ++m) _Pragma("unroll") for (int k = 0; k < 2; ++k) dst[m][k] = *(const LAS bf16x8*)(lds + PG8_SA(b, h) + aoff + m * 2048 + k * 1024); } while (0)
#define PG8_LDB(dst, b, h) do { _Pragma("unroll") for (int n = 0; n < 2; ++n) _Pragma("unroll") for (int k = 0; k < 2; ++k) dst[n][k] = *(const LAS bf16x8*)(lds + PG8_SB(b, h) + boff + n * 2048 + k * 1024); } while (0)
#define PG8_MMA(ai, bj, At, Bt) do { __builtin_amdgcn_s_setprio(1); _Pragma("unroll") for (int m = 0; m < 4; ++m) _Pragma("unroll") for (int n = 0; n < 2; ++n) _Pragma("unroll") for (int k = 0; k < 2; ++k) \
        acc[ai][bj][m][n] = __builtin_amdgcn_mfma_f32_16x16x32_bf16(Bt[n][k], At[m][k], acc[ai][bj][m][n], 0, 0, 0); __builtin_amdgcn_s_setprio(0); } while (0)
#define PG8_WAIT_V(n) asm volatile("s_waitcnt vmcnt(" #n ")" ::: "memory")
#define PG8_WAIT_L(n) asm volatile("s_waitcnt lgkmcnt(" #n ")" ::: "memory")
#define PG8_BAR __builtin_amdgcn_s_barrier()
#define PG8_SCHED __builtin_amdgcn_sched_barrier(0)
    Unit cur, nxt; int ui = 0;
    if (!S.next(0, cur)) return;
    f32x4 acc[2][2][4][2];
#pragma unroll
    for (int a = 0; a < 2; ++a)
#pragma unroll
        for (int b = 0; b < 2; ++b)
#pragma unroll
            for (int m = 0; m < 4; ++m)
#pragma unroll
                for (int n = 0; n < 2; ++n) acc[a][b][m][n] = (f32x4){0.f, 0.f, 0.f, 0.f};
    bf16x8 At[4][2], B0[2][2], B1[2][2];
    const char* cA = (const char*)g.A + S.aoff(cur); const char* cB = (const char*)g.Bt + S.boff(cur);
    PG8_STAGE(PG8_SB(0, 0), cB, voffB); PG8_STAGE(PG8_SB(0, 1), cB + hstepB, voffB); PG8_STAGE(PG8_SA(0, 0), cA, voffA); PG8_STAGE(PG8_SA(0, 1), cA + hstepA, voffA);
    if (wr == 1) PG8_BAR;
    PG8_WAIT_V(2); PG8_BAR;
    PG8_STAGE(PG8_SB(1, 0), cB + kstep, voffB); PG8_STAGE(PG8_SA(1, 0), cA + kstep, voffA); PG8_STAGE(PG8_SB(1, 1), cB + hstepB + kstep, voffB);
    PG8_WAIT_V(6); PG8_BAR;
    for (;;) {
        const bool has_next = S.next(ui + 1, nxt);
        const char* nA = has_next ? (const char*)g.A + S.aoff(nxt) : cA; const char* nB = has_next ? (const char*)g.Bt + S.boff(nxt) : cB;
        for (int t = 0; t < nt; t += 2) {
            const bool last = (t == nt - 2);
            const char* a1 = cA + (size_t)(t + 1) * kstep;
            const char* a2 = last ? nA : cA + (size_t)(t + 2) * kstep; const char* b2 = last ? nB : cB + (size_t)(t + 2) * kstep;
            const char* a3 = a2 + kstep; const char* b3 = b2 + kstep;
            PG8_LDB(B0, 0, 0); PG8_LDB(B1, 0, 1); PG8_SCHED; PG8_LDA(At, 0, 0); PG8_STAGE(PG8_SA(1, 1), a1 + hstepA, voffA);
            PG8_WAIT_V(8); PG8_WAIT_L(0); PG8_BAR; PG8_MMA(0, 0, At, B0); PG8_MMA(0, 1, At, B1); PG8_BAR; PG8_SCHED;
            PG8_LDA(At, 0, 1); PG8_STAGE(PG8_SB(0, 0), b2, voffB); PG8_STAGE(PG8_SB(0, 1), b2 + hstepB, voffB); PG8_STAGE(PG8_SA(0, 0), a2, voffA);
            PG8_WAIT_V(8); PG8_WAIT_L(0); PG8_BAR; PG8_MMA(1, 0, At, B0); PG8_MMA(1, 1, At, B1); PG8_BAR; PG8_SCHED;
            PG8_LDB(B0, 1, 0); PG8_LDB(B1, 1, 1); PG8_SCHED; PG8_LDA(At, 1, 0); PG8_STAGE(PG8_SA(0, 1), a2 + hstepA, voffA);
            PG8_WAIT_V(8); PG8_WAIT_L(0); PG8_BAR; PG8_MMA(0, 0, At, B0); PG8_MMA(0, 1, At, B1); PG8_BAR; PG8_SCHED;
            PG8_LDA(At, 1, 1); PG8_STAGE(PG8_SB(1, 0), b3, voffB); PG8_STAGE(PG8_SB(1, 1), b3 + hstepB, voffB); PG8_STAGE(PG8_SA(1, 0), a3, voffA);
            PG8_WAIT_V(8); PG8_WAIT_L(0); PG8_BAR; PG8_MMA(1, 0, At, B0); PG8_MMA(1, 1, At, B1); PG8_BAR; PG8_SCHED;
        }
        if (wr == 0) PG8_BAR;
        E(acc, cur, wr, wc, fr, fq);
        if (!has_next) break;
#pragma unroll
        for (int a = 0; a < 2; ++a)
#pragma unroll
            for (int b = 0; b < 2; ++b)
#pragma unroll
                for (int m = 0; m < 4; ++m)
#pragma unroll
                    for (int n = 0; n < 2; ++n) acc[a][b][m][n] = (f32x4){0.f, 0.f, 0.f, 0.f};
        cur = nxt; cA = nA; cB = nB; ++ui;
        if (wr == 1) PG8_BAR;
    }
    PG8_WAIT_V(0);
    PG8_BAR;
#undef PG8_SA
#undef PG8_SB
#undef PG8_STAGE
#undef PG8_LDA
#undef PG8_LDB
#undef PG8_MMA
#undef PG8_WAIT_V
#undef PG8_WAIT_L
#undef PG8_BAR
#undef PG8_SCHED
}

struct EpiStore {
    bf16_t* O; int ldc; int row_off; float scale;
    DI void operator()(const f32x4 (&acc)[2][2][4][2], const Unit& u, int wr, int wc, int fr, int fq) const {
        const int row0 = row_off + u.pm * BM + wr * 64 + fr, col0 = u.pn * BM + wc * 32 + 8 * fq;
#pragma unroll
        for (int ai = 0; ai < 2; ++ai)
#pragma unroll
            for (int m = 0; m < 4; ++m) { bf16_t* rowp = O + (size_t)(row0 + ai * HALF + m * 16) * ldc + col0;
#pragma unroll
                for (int bj = 0; bj < 2; ++bj) { const f32x4 v0 = acc[ai][bj][m][0] * scale, v1 = acc[ai][bj][m][1] * scale;
                    u32x4 w; w.x = cvtpk(v0[0], v0[1]); w.y = cvtpk(v0[2], v0[3]); w.z = cvtpk(v1[0], v1[1]); w.w = cvtpk(v1[2], v1[3]);
                    *(u32x4*)(rowp + bj * HALF) = w; } }
    }
};

DI f32x4 shfl4(f32x4 v, int src) { f32x4 r; r.x = __shfl(v.x, src); r.y = __shfl(v.y, src); r.z = __shfl(v.z, src); r.w = __shfl(v.w, src); return r; }

#define CONV_COL(ACC, AI, BJ, N, Z, CP, CM, CN) do { const f32x4 zero4_ = {0.f, 0.f, 0.f, 0.f}; \
    _Pragma("unroll") for (int m = 0; m < 4; ++m) { const f32x4 cur_ = ACC[AI][BJ][m][N]; \
        const f32x4 su_ = (fr == 15) ? (m > 0 ? ACC[AI][BJ][m > 0 ? m - 1 : 0][N] : zero4_) : cur_; \
        const f32x4 sd_ = (fr == 0) ? (m < 3 ? ACC[AI][BJ][m < 3 ? m + 1 : 3][N] : zero4_) : cur_; \
        f32x4 up_ = shfl4(su_, src_up), dn_ = shfl4(sd_, src_dn); \
        const int t_ = tok0 + 16 * m + fr; \
        if (is_first(t_)) up_ = zero4_; if (is_last(t_)) dn_ = zero4_; \
        Z[m] = CP * up_ + CM * cur_ + CN * dn_; } } while (0)
#define CONV_ONE(ACC, AI, BJ, N, M, Z, CP, CM, CN) do { const f32x4 zero4_ = {0.f, 0.f, 0.f, 0.f}; const f32x4 cur_ = ACC[AI][BJ][M][N]; \
        const f32x4 su_ = (fr == 15) ? (M > 0 ? ACC[AI][BJ][M > 0 ? M - 1 : 0][N] : zero4_) : cur_; \
        const f32x4 sd_ = (fr == 0) ? (M < 3 ? ACC[AI][BJ][M < 3 ? M + 1 : 3][N] : zero4_) : cur_; \
        f32x4 up_ = shfl4(su_, src_up), dn_ = shfl4(sd_, src_dn); \
        const int t_ = tok0 + 16 * M + fr; \
        if (is_first(t_)) up_ = zero4_; if (is_last(t_)) dn_ = zero4_; \
        Z = CP * up_ + CM * cur_ + CN * dn_; } while (0)
#define ROW_VALID(m) ((16 * (m) + fr >= 1) && (16 * (m) + fr <= 62) && (tok0 + 16 * (m) + fr < T))

struct EpiIn {
    const float* mu_prev; const float* mu_next; bf16_t* UTS_; bf16_t* UTP_; bf16_t* RKV_; bf16_t* LD_;
    DI void operator()(const f32x4 (&acc)[2][2][4][2], const Unit& u, int wr, int wc, int fr_, int fq_) const {
        int fr = fr_, fq = fq_; asm volatile("" : "+v"(fr), "+v"(fq));
        const int lane = fr | (fq << 4);
        const int src_up = (lane & 48) | ((fr + 15) & 15), src_dn = (lane & 48) | ((fr + 1) & 15);
        if (u.pn < 2) {
#pragma unroll
            for (int ai = 0; ai < 2; ++ai) {
                const int tok0 = u.pm * 248 + (2 * ai + wr) * 62 - 1;
#pragma unroll
                for (int m = 0; m < 4; ++m) {
                    if (ROW_VALID(m)) { const int t = tok0 + 16 * m + fr; const bool smp = t >= TPR;
                        const int s_ = smp ? (t & (SL - 1)) : (t >> 2); const int rb = (smp ? 4 + ((t - TPR) >> 12) : (t & 3)) * 512;
#pragma unroll
                        for (int bj = 0; bj < 2; ++bj) { const int c0 = u.pn * BM + bj * HALF + wc * 32 + 8 * fq;
#pragma unroll
                            for (int n = 0; n < 2; ++n)
#pragma unroll
                                for (int e = 0; e < 4; ++e) UTS_[((size_t)(rb + c0 + 4 * n + e)) * 4096 + s_] = f2bf(acc[ai][bj][m][n][e]); }
                    }
                    __builtin_amdgcn_sched_barrier(0); }
            }
        } else {
#pragma unroll
            for (int bj = 0; bj < 2; ++bj) {
                const int zc0 = u.pn * BM + bj * HALF + wc * 32 + 8 * fq - 512;
                if (zc0 >= ZR) continue;
                const int act = zc0 < 1536 ? 0 : (zc0 < 1664 ? 1 : (zc0 < 1792 ? 0 : 2));
#pragma unroll
                for (int n = 0; n < 2; ++n) { const f32x4 cp = *(const f32x4*)(mu_prev + zc0 + 4 * n), cn = *(const f32x4*)(mu_next + zc0 + 4 * n); const f32x4 cm = 1.f - cp - cn;
#pragma unroll
                    for (int ai = 0; ai < 2; ++ai) {
                        const int tok0 = u.pm * 248 + (2 * ai + wr) * 62 - 1;
#pragma unroll
                        for (int m = 0; m < 4; ++m) { f32x4 z;
                            CONV_ONE(acc, ai, bj, n, m, z, cp, cm, cn);
                            if (act == 1) {
#pragma unroll
                                for (int e = 0; e < 4; ++e) z[e] = 1.f - 2.f * __builtin_amdgcn_rcpf(1.f + __expf(2.f * z[e])); }
                            if (act == 2) {
#pragma unroll
                                for (int e = 0; e < 4; ++e) z[e] = sigmoidf_(z[e]); }
                            if (ROW_VALID(m)) { const int t = tok0 + 16 * m + fr; u32x2 w; w.x = cvtpk(z[0], z[1]); w.y = cvtpk(z[2], z[3]);
                                if (zc0 < 1536) *(u32x2*)(RKV_ + (size_t)t * 1536 + zc0 + 4 * n) = w; else *(u32x2*)(LD_ + (size_t)t * 384 + (zc0 - 1536) + 4 * n) = w; }
                            __builtin_amdgcn_sched_barrier(0); }
                    }
                }
            }
        }
    }
};

struct EpiUp {
    const float* cw; const float* cb; bf16_t* ACT;
    DI void operator()(const f32x4 (&acc)[2][2][4][2], const Unit& u, int wr, int wc, int fr_, int fq_) const {
        int fr = fr_, fq = fq_; asm volatile("" : "+v"(fr), "+v"(fq));
        const int lane = fr | (fq << 4);
        const int src_up = (lane & 48) | ((fr + 15) & 15), src_dn = (lane & 48) | ((fr + 1) & 15);
        const int cv0 = u.pn * 128 + wc * 32 + 8 * fq;
#pragma unroll
        for (int n = 0; n < 2; ++n) {
            const int sv = cv0 + 4 * n, sg = FF + cv0 + 4 * n;
            const f32x4 vp = *(const f32x4*)(cw + sv), vm = *(const f32x4*)(cw + NUP + sv), vn = *(const f32x4*)(cw + 2 * NUP + sv), vb = *(const f32x4*)(cb + sv);
            const f32x4 gp = *(const f32x4*)(cw + sg), gm = *(const f32x4*)(cw + NUP + sg), gn = *(const f32x4*)(cw + 2 * NUP + sg), gb = *(const f32x4*)(cb + sg);
#pragma unroll
            for (int ai = 0; ai < 2; ++ai) {
                const int tok0 = u.pm * 248 + (2 * ai + wr) * 62 - 1;
#pragma unroll
                for (int m = 0; m < 4; ++m) { f32x4 zv, zg;
                    CONV_ONE(acc, ai, 0, n, m, zv, vp, vm, vn); CONV_ONE(acc, ai, 1, n, m, zg, gp, gm, gn);
                    zv = zv + vb; zg = zg + gb;
                    float ov[4];
#pragma unroll
                    for (int e = 0; e < 4; ++e) { const float x = zg[e]; const float uu = 1.5957691216f * (x + 0.044715f * x * x * x);
                        ov[e] = zv[e] * x * __builtin_amdgcn_rcpf(1.f + __expf(-uu)); }
                    if (ROW_VALID(m)) { const int t = tok0 + 16 * m + fr; u32x2 w; w.x = cvtpk(ov[0], ov[1]); w.y = cvtpk(ov[2], ov[3]);
                        *(u32x2*)(ACT + (size_t)t * FF + cv0 + 4 * n) = w; }
                    __builtin_amdgcn_sched_barrier(0); }
            }
        }
    }
};

struct EpiQkv {
    const float* ropec; const float* ropes; bf16_t* Q;
    DI void operator()(const f32x4 (&acc)[2][2][4][2], const Unit& u, int wr, int wc, int fr_, int fq_) const {
        int fr = fr_, fq = fq_; asm volatile("" : "+v"(fr), "+v"(fq));
        const int which = u.pn >> 2;
        bf16_t* base = Q + (size_t)which * ((size_t)T * 1024);
        const int i0 = 16 * (wc & 1) + 4 * fq;
#pragma unroll
        for (int ai = 0; ai < 2; ++ai)
#pragma unroll
            for (int m = 0; m < 4; ++m) { const int t = u.pm * BM + ai * HALF + wr * 64 + m * 16 + fr;
                f32x4 c4 = (f32x4){1.f, 1.f, 1.f, 1.f}, s4 = (f32x4){0.f, 0.f, 0.f, 0.f};
                if (which < 2) { const int pos = seq_pos(t); c4 = *(const f32x4*)(ropec + pos * 32 + i0); s4 = *(const f32x4*)(ropes + pos * 32 + i0); }
#pragma unroll
                for (int bj = 0; bj < 2; ++bj) { const f32x4 x1 = acc[ai][bj][m][0], x2 = acc[ai][bj][m][1];
                    f32x4 y1 = x1, y2 = x2;
                    if (which < 2) { y1 = x1 * c4 - x2 * s4; y2 = x2 * c4 + x1 * s4; }
                    if (which == 0) { y1 = y1 * (0.125f * 1.4426950408889634f); y2 = y2 * (0.125f * 1.4426950408889634f); }
                    u32x4 w; w.x = cvtpk(y1[0], y1[1]); w.y = cvtpk(y1[2], y1[3]); w.z = cvtpk(y2[0], y2[1]); w.w = cvtpk(y2[2], y2[3]);
                    *(u32x4*)(base + (size_t)t * 1024 + (u.pn & 3) * BM + bj * HALF + wc * 32 + 8 * fq) = w; } }
    }
};
}

namespace att {
constexpr int NW = 8, QBLK = 32, KVBLK = 64, LDQ = 1024;
constexpr float SCALE = 0.125f, THR = 8.f;
constexpr int SHM_V = KVBLK * 128 * 2, SHM_K = KVBLK * 64 * 2;
#define KSWZ(row, colB) ((row) * 128 + ((colB) ^ ((((row) >> 1) & 7) << 4)))
#define SBAR() __builtin_amdgcn_sched_barrier(0)
DI int crow(int r, int hi) { return (r & 3) + 8 * (r >> 2) + 4 * hi; }
DI void partialSM(f32x16& p0, f32x16& p1, float& m_reg, f32x16& negm, float& alpha) {
    constexpr float THR2 = THR * 1.4426950408889634f;
    float pmax = p0[0];
#pragma unroll
    for (int r = 1; r < 16; ++r) pmax = fmaxf(pmax, p0[r]);
#pragma unroll
    for (int r = 0; r < 16; ++r) pmax = fmaxf(pmax, p1[r]);
    { auto rr = __builtin_amdgcn_permlane32_swap(__float_as_uint(pmax), __float_as_uint(pmax), false, false);
      pmax = fmaxf(__uint_as_float(rr[0]), __uint_as_float(rr[1])); }
    const bool first = m_reg < -1e29f;
    if (__builtin_expect(__all(!first && pmax <= THR2), 1)) { alpha = 1.f; }
    else {
        const float d = first ? pmax : fmaxf(pmax, 0.f);
        alpha = first ? 0.f : __builtin_amdgcn_exp2f(-d);
        m_reg = first ? pmax : m_reg + d;
#pragma unroll
        for (int r = 0; r < 16; ++r) { p0[r] -= d; p1[r] -= d; negm[r] = -m_reg; }
    }
#pragma unroll
    for (int r = 0; r < 16; ++r) p0[r] = __builtin_amdgcn_exp2f(p0[r]);
}
DI void finishSM(f32x16& p0, f32x16& p1, float alpha, float& l_reg, bf16x8& pa0, bf16x8& pa1, bf16x8& pa2, bf16x8& pa3) {
#pragma unroll
    for (int r = 0; r < 16; ++r) p1[r] = __builtin_amdgcn_exp2f(p1[r]);
    float ps = 0;
#pragma unroll
    for (int r = 0; r < 16; ++r) ps += p0[r];
#pragma unroll
    for (int r = 0; r < 16; ++r) ps += p1[r];
    { auto rr = __builtin_amdgcn_permlane32_swap(__float_as_uint(ps), __float_as_uint(ps), false, false);
      ps = __uint_as_float(rr[0]) + __uint_as_float(rr[1]); }
    l_reg = l_reg * alpha + ps;
#define PK4(P, BASE, OUT) do { unsigned a0 = cvtpk(P[BASE + 0], P[BASE + 1]), a1 = cvtpk(P[BASE + 2], P[BASE + 3]);   \
    unsigned b0 = cvtpk(P[BASE + 4], P[BASE + 5]), b1 = cvtpk(P[BASE + 6], P[BASE + 7]);                              \
    auto r0 = __builtin_amdgcn_permlane32_swap(a0, b0, false, false); auto r1 = __builtin_amdgcn_permlane32_swap(a1, b1, false, false); \
    u32x4 w = {r0[0], r1[0], r0[1], r1[1]}; OUT = __builtin_bit_cast(bf16x8, w); } while (0)
    PK4(p0, 0, pa0); PK4(p0, 8, pa1); PK4(p1, 0, pa2); PK4(p1, 8, pa3);
#undef PK4
}
DI void qkt(f32x16& p0, f32x16& p1, const char* Ks, const bf16x8* qr, const f32x16& negm, int r32, int hi) {
    { const bf16x8 b0 = *reinterpret_cast<const bf16x8*>(Ks + KSWZ(r32, hi * 16));
      const bf16x8 b1 = *reinterpret_cast<const bf16x8*>(Ks + KSWZ(32 + r32, hi * 16));
      p0 = __builtin_amdgcn_mfma_f32_32x32x16_bf16(b0, qr[0], negm, 0, 0, 0);
      p1 = __builtin_amdgcn_mfma_f32_32x32x16_bf16(b1, qr[0], negm, 0, 0, 0); }
#pragma unroll
    for (int d0 = 1; d0 < 4; ++d0) { const int cb = (d0 * 16 + hi * 8) * 2;
        const bf16x8 b0 = *reinterpret_cast<const bf16x8*>(Ks + KSWZ(r32, cb));
        const bf16x8 b1 = *reinterpret_cast<const bf16x8*>(Ks + KSWZ(32 + r32, cb));
        p0 = __builtin_amdgcn_mfma_f32_32x32x16_bf16(b0, qr[d0], p0, 0, 0, 0);
        p1 = __builtin_amdgcn_mfma_f32_32x32x16_bf16(b1, qr[d0], p1, 0, 0, 0); }
}
DI int v_st(int k, int c) { const int kk = (k & ~0xC) | ((k & 4) << 1) | ((k & 8) >> 1); return ((kk >> 3) * 4 + (c >> 5)) * 512 + ((kk & 7) * 32 + (c & 31)) * 2; }
DI int v_rd_base(int lane) { return ((lane & 3) << 3) | (((lane >> 2) & 3) << 6) | (((lane >> 4) & 1) << 5) | (((lane >> 5) & 1) << 8); }
constexpr int v_rd_off(int d0, int ks, int half) { return d0 * 512 + ks * 4096 + half * 2048; }
template <int OFF> DI s16x4 tr_read(int vb) { s16x4 r; asm volatile("ds_read_b64_tr_b16 %0, %1 offset:%2" : "=&v"(r) : "v"(vb), "i"(OFF) : "memory"); return r; }
template <int D0> DI void pv_one(f32x16& od, int vb, bf16x8 pa0, bf16x8 pa1, bf16x8 pa2, bf16x8 pa3) {
    const s16x4 l0 = tr_read<v_rd_off(D0, 0, 0)>(vb), h0 = tr_read<v_rd_off(D0, 0, 1)>(vb), l1 = tr_read<v_rd_off(D0, 1, 0)>(vb), h1 = tr_read<v_rd_off(D0, 1, 1)>(vb);
    const s16x4 l2 = tr_read<v_rd_off(D0, 2, 0)>(vb), h2 = tr_read<v_rd_off(D0, 2, 1)>(vb), l3 = tr_read<v_rd_off(D0, 3, 0)>(vb), h3 = tr_read<v_rd_off(D0, 3, 1)>(vb);
    asm volatile("s_waitcnt lgkmcnt(0)" ::: "memory"); SBAR();
#define PKV(L, H) (bf16x8){L[0], L[1], L[2], L[3], H[0], H[1], H[2], H[3]}
    od = __builtin_amdgcn_mfma_f32_32x32x16_bf16(pa0, PKV(l0, h0), od, 0, 0, 0);
    od = __builtin_amdgcn_mfma_f32_32x32x16_bf16(pa1, PKV(l1, h1), od, 0, 0, 0);
    od = __builtin_amdgcn_mfma_f32_32x32x16_bf16(pa2, PKV(l2, h2), od, 0, 0, 0);
    od = __builtin_amdgcn_mfma_f32_32x32x16_bf16(pa3, PKV(l3, h3), od, 0, 0, 0);
#undef PKV
}
DI void pv_d0(f32x16* o, int vb, bf16x8 pa0, bf16x8 pa1, bf16x8 pa2, bf16x8 pa3) {
    pv_one<0>(o[0], vb, pa0, pa1, pa2, pa3); pv_one<1>(o[1], vb, pa0, pa1, pa2, pa3); pv_one<2>(o[2], vb, pa0, pa1, pa2, pa3); pv_one<3>(o[3], vb, pa0, pa1, pa2, pa3);
}

DI void attn_pass(const bf16_t* __restrict__ Qb, const bf16_t* __restrict__ Kh, const bf16_t* __restrict__ Vh, int seq, char* lds, f32x16 (&o)[4], float& l_out) {
    int tid_ = threadIdx.x; asm volatile("" : "+v"(tid_));
    const int tid = tid_, wid = tid >> 6, lane = tid & 63, r32 = lane & 31, hi = lane >> 5;
    char* V_lds = lds; char* K_lds = lds + 2 * SHM_V;
    float* ws = (float*)(lds + 2 * SHM_V + 2 * SHM_K) + wid * 64; float* al_l = ws + 32;
    float m_reg = -1e30f, l_reg = 0; bf16x8 qr[4]; f32x16 negm;
#pragma unroll
    for (int r = 0; r < 16; ++r) negm[r] = 0.f;
#pragma unroll
    for (int d = 0; d < 4; ++d)
#pragma unroll
        for (int r = 0; r < 16; ++r) o[d][r] = 0.f;
    const bf16_t* Qw = Qb + (size_t)(wid * QBLK + r32) * LDQ + hi * 8;
#pragma unroll
    for (int d0 = 0; d0 < 4; ++d0) qr[d0] = *reinterpret_cast<const bf16x8*>(Qw + d0 * 16);
    const int sr = tid >> 4, sc = (tid & 15) * 8, vst0 = v_st(sr, sc), vst1 = v_st(32 + sr, sc);
    const int kr = tid >> 3, kc = (tid & 7) * 8, kst = KSWZ(kr, kc * 2);
    const int vb0 = (int)(uintptr_t)V_lds + v_rd_base(lane);
    bf16x8 vsA0, vsA1, ksA, vsB0, vsB1, ksB;
#define SLOADA(k0) do { vsA0 = *reinterpret_cast<const bf16x8*>(&Vh[(size_t)((k0) + sr) * LDQ + sc]); vsA1 = *reinterpret_cast<const bf16x8*>(&Vh[(size_t)((k0) + 32 + sr) * LDQ + sc]); \
    ksA = *reinterpret_cast<const bf16x8*>(&Kh[(size_t)((k0) + kr) * LDQ + kc]); } while (0)
#define SLOADB(k0) do { vsB0 = *reinterpret_cast<const bf16x8*>(&Vh[(size_t)((k0) + sr) * LDQ + sc]); vsB1 = *reinterpret_cast<const bf16x8*>(&Vh[(size_t)((k0) + 32 + sr) * LDQ + sc]); \
    ksB = *reinterpret_cast<const bf16x8*>(&Kh[(size_t)((k0) + kr) * LDQ + kc]); } while (0)
#define SWRITEA(b) do { *(bf16x8*)(V_lds + (b) * SHM_V + vst0) = vsA0; *(bf16x8*)(V_lds + (b) * SHM_V + vst1) = vsA1; *(bf16x8*)(K_lds + (b) * SHM_K + kst) = ksA; } while (0)
#define SWRITEB(b) do { *(bf16x8*)(V_lds + (b) * SHM_V + vst0) = vsB0; *(bf16x8*)(V_lds + (b) * SHM_V + vst1) = vsB1; *(bf16x8*)(K_lds + (b) * SHM_K + kst) = ksB; } while (0)
#define SWAIT() asm volatile("s_waitcnt vmcnt(3)" ::: "memory")
#define RESC(a) do { if (__any((a) < 1.f)) { if (hi == 0) al_l[r32] = (a); asm volatile("s_waitcnt lgkmcnt(0)" ::: "memory"); \
    _Pragma("unroll") for (int d = 0; d < 4; ++d) _Pragma("unroll") for (int r = 0; r < 16; ++r) o[d][r] *= al_l[crow(r, hi)]; } } while (0)
    f32x16 pA0, pA1, pB0, pB1; float alA, alB; bf16x8 pa0, pa1, pa2, pa3; const int NT = seq / KVBLK;
    SLOADA(0); asm volatile("s_waitcnt vmcnt(0)" ::: "memory"); SWRITEA(0); __syncthreads();
    qkt(pA0, pA1, K_lds, qr, negm, r32, hi); partialSM(pA0, pA1, m_reg, negm, alA);
    SLOADB(KVBLK); if (2 < NT) SLOADA(2 * KVBLK);
    SWAIT(); SWRITEB(1); __syncthreads();
    for (int j = 1; j + 1 < NT; j += 2) {
        SBAR(); qkt(pB0, pB1, K_lds + SHM_K, qr, negm, r32, hi);
        finishSM(pA0, pA1, alA, l_reg, pa0, pa1, pa2, pa3); SBAR();
        SLOADB((j + 2) * KVBLK); SBAR();
        pv_d0(o, vb0, pa0, pa1, pa2, pa3); partialSM(pB0, pB1, m_reg, negm, alB);
        __syncthreads(); SWAIT(); SWRITEA(0);
        RESC(alB); __syncthreads();
        SBAR(); qkt(pA0, pA1, K_lds, qr, negm, r32, hi);
        finishSM(pB0, pB1, alB, l_reg, pa0, pa1, pa2, pa3); SBAR();
        if (j + 3 < NT) SLOADA((j + 3) * KVBLK); SBAR();
        pv_d0(o, vb0 + SHM_V, pa0, pa1, pa2, pa3); partialSM(pA0, pA1, m_reg, negm, alA);
        __syncthreads(); if (j + 3 < NT) SWAIT(); else asm volatile("s_waitcnt vmcnt(0)" ::: "memory"); SWRITEB(1);
        RESC(alA); __syncthreads();
    }
    SBAR(); qkt(pB0, pB1, K_lds + SHM_K, qr, negm, r32, hi);
    finishSM(pA0, pA1, alA, l_reg, pa0, pa1, pa2, pa3); SBAR();
    pv_d0(o, vb0, pa0, pa1, pa2, pa3); partialSM(pB0, pB1, m_reg, negm, alB);
    __syncthreads(); RESC(alB);
    finishSM(pB0, pB1, alB, l_reg, pa0, pa1, pa2, pa3); SBAR();
    pv_d0(o, vb0 + SHM_V, pa0, pa1, pa2, pa3);
    l_out = l_reg;
#undef SLOADA
#undef SLOADB
#undef SWRITEA
#undef SWRITEB
#undef SWAIT
#undef RESC
}
}

DI void tr_item(const float* W, int ldw, int K, bf16_t* WT, int n0, int k0, int srccol, int lane, LAS float* scr) {
#pragma unroll 8
    for (int i = 0; i < 32; ++i) { const int kk = 2 * i + (lane >> 5); scr[kk * 33 + (lane & 31)] = srccol >= 0 ? W[(size_t)(k0 + kk) * ldw + srccol] : 0.f; }
    asm volatile("s_waitcnt lgkmcnt(0)" ::: "memory");
    const int c = lane & 7;
#pragma unroll
    for (int j = 0; j < 4; ++j) { const int n = (lane >> 3) + 8 * j; const LAS float* s = scr + (8 * c) * 33 + n;
        u32x4 o; o.x = cvtpk(s[0 * 33], s[1 * 33]); o.y = cvtpk(s[2 * 33], s[3 * 33]); o.z = cvtpk(s[4 * 33], s[5 * 33]); o.w = cvtpk(s[6 * 33], s[7 * 33]);
        *(u32x4*)(WT + (size_t)(n0 + n) * K + k0 + 8 * c) = o; }
    asm volatile("s_waitcnt lgkmcnt(0)" ::: "memory");
}

DI void row_item(const float* xrow, const bf16_t* hrow, const float* gpost, float* orow, const float* gpre, bf16_t* hnrow, int lane) {
    f32x4 v[4];
#pragma unroll
    for (int j = 0; j < 4; ++j) v[j] = *((const f32x4*)xrow + lane + 64 * j);
    if (hrow) {
        f32x4 h[4]; float s = 0.f;
#pragma unroll
        for (int j = 0; j < 4; ++j) { const u32x2 w = *((const u32x2*)hrow + lane + 64 * j); h[j] = (f32x4){bflo(w.x), bfhi(w.x), bflo(w.y), bfhi(w.y)};
            s += (h[j].x * h[j].x + h[j].y * h[j].y) + (h[j].z * h[j].z + h[j].w * h[j].w); }
        const float rs = rsqrtf(wave_sum(s) * (1.f / DM) + 1e-6f);
#pragma unroll
        for (int j = 0; j < 4; ++j) { const f32x4 g = *((const f32x4*)gpost + lane + 64 * j); v[j] = v[j] + h[j] * rs * g; *((f32x4*)orow + lane + 64 * j) = v[j]; }
    }
    if (gpre) {
        float s = 0.f;
#pragma unroll
        for (int j = 0; j < 4; ++j) s += (v[j].x * v[j].x + v[j].y * v[j].y) + (v[j].z * v[j].z + v[j].w * v[j].w);
        const float rs = rsqrtf(wave_sum(s) * (1.f / DM) + 1e-6f);
#pragma unroll
        for (int j = 0; j < 4; ++j) { const f32x4 g = *((const f32x4*)gpre + lane + 64 * j); const f32x4 y = v[j] * rs * g;
            u32x2 w; w.x = cvtpk(y.x, y.y); w.y = cvtpk(y.z, y.w); *((u32x2*)hnrow + lane + 64 * j) = w; }
    }
}

DI void row_item2(const float* xa, const float* xb, const bf16_t* ha, const bf16_t* hb, const float* gpost, float* oa, float* ob, const float* gpre, bf16_t* hna, bf16_t* hnb, int lane) {
    f32x4 va[4], vb[4]; u32x2 wa[4], wb[4];
#pragma unroll
    for (int j = 0; j < 4; ++j) { va[j] = __builtin_nontemporal_load((const f32x4*)xa + lane + 64 * j); vb[j] = __builtin_nontemporal_load((const f32x4*)xb + lane + 64 * j); }
    if (ha) {
#pragma unroll
        for (int j = 0; j < 4; ++j) { wa[j] = *((const u32x2*)ha + lane + 64 * j); wb[j] = *((const u32x2*)hb + lane + 64 * j); }
        f32x4 h[4]; float s = 0.f;
#pragma unroll
        for (int j = 0; j < 4; ++j) { const u32x2 w = wa[j]; h[j] = (f32x4){bflo(w.x), bfhi(w.x), bflo(w.y), bfhi(w.y)}; s += (h[j].x * h[j].x + h[j].y * h[j].y) + (h[j].z * h[j].z + h[j].w * h[j].w); }
        float rs = rsqrtf(wave_sum(s) * (1.f / DM) + 1e-6f);
#pragma unroll
        for (int j = 0; j < 4; ++j) { const f32x4 g = *((const f32x4*)gpost + lane + 64 * j); va[j] = va[j] + h[j] * rs * g; __builtin_nontemporal_store(va[j], (f32x4*)oa + lane + 64 * j); }
        s = 0.f;
#pragma unroll
        for (int j = 0; j < 4; ++j) { const u32x2 w = wb[j]; h[j] = (f32x4){bflo(w.x), bfhi(w.x), bflo(w.y), bfhi(w.y)}; s += (h[j].x * h[j].x + h[j].y * h[j].y) + (h[j].z * h[j].z + h[j].w * h[j].w); }
        rs = rsqrtf(wave_sum(s) * (1.f / DM) + 1e-6f);
#pragma unroll
        for (int j = 0; j < 4; ++j) { const f32x4 g = *((const f32x4*)gpost + lane + 64 * j); vb[j] = vb[j] + h[j] * rs * g; __builtin_nontemporal_store(vb[j], (f32x4*)ob + lane + 64 * j); }
    }
    if (gpre) {
        float s = 0.f, t = 0.f;
#pragma unroll
        for (int j = 0; j < 4; ++j) { s += (va[j].x * va[j].x + va[j].y * va[j].y) + (va[j].z * va[j].z + va[j].w * va[j].w); t += (vb[j].x * vb[j].x + vb[j].y * vb[j].y) + (vb[j].z * vb[j].z + vb[j].w * vb[j].w); }
        const float rsa = rsqrtf(wave_sum(s) * (1.f / DM) + 1e-6f), rsb = rsqrtf(wave_sum(t) * (1.f / DM) + 1e-6f);
#pragma unroll
        for (int j = 0; j < 4; ++j) { const f32x4 g = *((const f32x4*)gpre + lane + 64 * j); const f32x4 ya = va[j] * rsa * g, yb = vb[j] * rsb * g;
            u32x2 w; w.x = cvtpk(ya.x, ya.y); w.y = cvtpk(ya.z, ya.w); *((u32x2*)hna + lane + 64 * j) = w;
            u32x2 w2; w2.x = cvtpk(yb.x, yb.y); w2.y = cvtpk(yb.z, yb.w); *((u32x2*)hnb + lane + 64 * j) = w2; }
    }
}

typedef const __attribute__((address_space(4))) Args* ArgsP;
DI ArgsP getargs() { unsigned long long kp = (unsigned long long)__builtin_amdgcn_kernarg_segment_ptr(); asm volatile("" : "+s"(kp)); return (ArgsP)kp; }
#define WSB (getargs()->ws)
#define DOB ((unsigned char*)getargs()->out)
#define x_prompt (getargs()->in[0])
#define x_sample (getargs()->in[1])
#define W_IN ((bf16_t*)(WSB + WS_WIN))
#define W_G ((bf16_t*)(WSB + WS_WG))
#define W_OUT0 ((bf16_t*)(WSB + WS_WOUT0))
#define W_UP ((bf16_t*)(WSB + WS_WUP))
#define W_DN ((bf16_t*)(WSB + WS_WDN))
#define W_QKV ((bf16_t*)(WSB + WS_WQKV))
#define W_O ((bf16_t*)(WSB + WS_WO))
#define ROPEC ((float*)(WSB + WS_ROPE))
#define ROPES (ROPEC + TPR * 32)
#define BONUS ((float*)(WSB + WS_BONUS))
#define DFTM ((bf16_t*)(WSB + WS_DFT))
#define HN ((bf16_t*)(WSB + WS_HN))
#define RKV ((bf16_t*)(WSB + WS_RKV))
#define LDB ((bf16_t*)(WSB + WS_LD))
#define GATE ((bf16_t*)(WSB + WS_GATE))
#define YC ((bf16_t*)(WSB + WS_YC))
#define RAWB ((bf16_t*)(WSB + WS_RAWB))
#define ACT ((bf16_t*)(WSB + WS_ACT))
#define QB ((bf16_t*)(WSB + WS_Q))
#define KB ((bf16_t*)(WSB + WS_K))
#define VB ((bf16_t*)(WSB + WS_V))
#define UTS ((bf16_t*)(DOB + DO_UTS))
#define UTP ((bf16_t*)(DOB + DO_UTP))
#define YF ((bf16_t*)(DOB + DO_YF))
#define YB ((bf16_t*)(DOB + DO_YB))
#define YCS ((bf16_t*)(WSB + 448 * MiB))
#define SSB ((bf16_t*)(DOB + DO_SS))

template <bool WITH_P, bool FROM_STATE, bool WITH_Y, bool STORE_E>
DI void scan_unit(LAS unsigned char* lds, const int sq, const int h, const int d, const int seg, const int nseg) {
    int tid_l = threadIdx.x; asm volatile("" : "+v"(tid_l)); const int tid = tid_l, lane = tid & 63, wave = __builtin_amdgcn_readfirstlane(tid >> 6);
    const int s0 = sq == 0 ? 0 : TPR + (sq - 1) * SL, len = sq == 0 ? TPR : SL, seglen = len / nseg, p0 = seg * seglen;
    const int u = sq * 16 + h * 2 + d;
    float* EST = (float*)(DOB + 96 * MiB); float* PST = (float*)(DOB + 128 * MiB);
    LAS float* Wd = (LAS float*)lds; LAS float* Aa = Wd + 2048; LAS float* Bb = Aa + 2048; LAS float* Kd = Bb + 2048; LAS float* Rr = Kd + 2048; LAS float* Vv = Rr + 2048;
    LAS float* WL = Vv + 2048; LAS float* AL = WL + 2048; LAS float* Yb = AL + 2048; LAS float* Sx = Yb + 2048;
    const float* w0 = getargs()->in[7] + d * 512 + h * 64; const float* w2 = getargs()->in[8] + (size_t)d * 64 * 512 + h * 64;
    const float* a0 = getargs()->in[9] + d * 512 + h * 64; const float* a2 = getargs()->in[10] + (size_t)d * 64 * 512 + h * 64;
    const float* kkp = getargs()->in[12] + h * 64; const float* kap = getargs()->in[13] + h * 64; const float* rkp = getargs()->in[14] + h * 64;
    bf16_t* YD = d ? YB : YF; float* BON = BONUS + (size_t)d * T * 8;
    const int mt = wave & 1, ntile = wave >> 1;
    bf16x8 bw[2], ba[2];
#pragma unroll
    for (int ks = 0; ks < 2; ++ks) { float fw[8], fa[8];
#pragma unroll
        for (int j = 0; j < 8; ++j) { const int k = ks * 32 + (lane >> 4) * 8 + j; fw[j] = w2[(size_t)k * 512 + ntile * 16 + (lane & 15)]; fa[j] = a2[(size_t)k * 512 + ntile * 16 + (lane & 15)]; }
        u32x4 pw = {cvtpk(fw[0], fw[1]), cvtpk(fw[2], fw[3]), cvtpk(fw[4], fw[5]), cvtpk(fw[6], fw[7])}; bw[ks] = __builtin_bit_cast(bf16x8, pw);
        u32x4 pa = {cvtpk(fa[0], fa[1]), cvtpk(fa[2], fa[3]), cvtpk(fa[4], fa[5]), cvtpk(fa[6], fa[7])}; ba[ks] = __builtin_bit_cast(bf16x8, pa); }
    const int pi = tid >> 4, pc = (tid & 15) * 4;
    const f32x4 w0v = *(const f32x4*)(w0 + pc), a0v = *(const f32x4*)(a0 + pc), kkv = *(const f32x4*)(kkp + pc), kav = *(const f32x4*)(kap + pc), rkv = *(const f32x4*)(rkp + pc);
    const int rl = lane >> 3, cgp = lane & 7, row = 8 * wave + rl;
    float st[8], sp[8];
#pragma unroll
    for (int j = 0; j < 8; ++j) { st[j] = 0.f; sp[j] = (8 * cgp + j == row) ? 1.f : 0.f; }
    if (FROM_STATE) {
        const float* e0 = EST + ((size_t)(u * 8 + 0) * 64 + row) * 64 + 8 * cgp;
#pragma unroll
        for (int j = 0; j < 8; ++j) st[j] = e0[j];
        for (int i = 1; i < seg; ++i) {
#pragma unroll
            for (int j = 0; j < 8; ++j) Sx[row * 64 + 8 * cgp + j] = st[j];
            __syncthreads();
            const float* ei = EST + ((size_t)(u * 8 + i) * 64 + row) * 64 + 8 * cgp; const float* pp = PST + (size_t)(u * 8 + i) * 4096 + 8 * cgp;
            float ac[8];
#pragma unroll
            for (int j = 0; j < 8; ++j) ac[j] = ei[j];
            for (int k = 0; k < 64; ++k) { const float sk = Sx[row * 64 + k]; const f32x4 q0 = *(const f32x4*)(pp + k * 64), q1 = *(const f32x4*)(pp + k * 64 + 4);
#pragma unroll
                for (int j = 0; j < 4; ++j) { ac[j] += sk * q0[j]; ac[4 + j] += sk * q1[j]; } }
#pragma unroll
            for (int j = 0; j < 8; ++j) st[j] = ac[j];
            __syncthreads();
        }
    }
    f32x2 st2[4], sp2[4];
#pragma unroll
    for (int j = 0; j < 4; ++j) { st2[j] = (f32x2){st[2 * j], st[2 * j + 1]}; sp2[j] = (f32x2){sp[2 * j], sp[2 * j + 1]}; }
    const int nch = seglen / 32;
    u32x2 pr, pk_, pv; bf16x8 fa_w[2], fa_a[2];
#define SCAN_TOK(c, i) (d ? (s0 + len - 1 - (p0 + (c) * 32 + (i))) : (s0 + p0 + (c) * 32 + (i)))
#define SCAN_LOAD(c) do { const int t_ = SCAN_TOK(c, pi); const bf16_t* rp = RKV + (size_t)t_ * 1536 + h * 64 + pc; \
    pr = *(const u32x2*)rp; pk_ = *(const u32x2*)(rp + 512); pv = *(const u32x2*)(rp + 1024); \
    const int ta_ = SCAN_TOK(c, mt * 16 + (lane & 15)); const bf16_t* lp = LDB + (size_t)ta_ * 384 + d * 64 + (lane >> 4) * 8; \
    fa_w[0] = *(const bf16x8*)lp; fa_w[1] = *(const bf16x8*)(lp + 32); fa_a[0] = *(const bf16x8*)(lp + 128); fa_a[1] = *(const bf16x8*)(lp + 160); } while (0)
    SCAN_LOAD(0);
    for (int c = 0; c < nch; ++c) {
        { f32x4 cw_ = {0.f, 0.f, 0.f, 0.f}, ca_ = {0.f, 0.f, 0.f, 0.f};
          cw_ = __builtin_amdgcn_mfma_f32_16x16x32_bf16(fa_w[0], bw[0], cw_, 0, 0, 0); cw_ = __builtin_amdgcn_mfma_f32_16x16x32_bf16(fa_w[1], bw[1], cw_, 0, 0, 0);
          ca_ = __builtin_amdgcn_mfma_f32_16x16x32_bf16(fa_a[0], ba[0], ca_, 0, 0, 0); ca_ = __builtin_amdgcn_mfma_f32_16x16x32_bf16(fa_a[1], ba[1], ca_, 0, 0, 0);
#pragma unroll
          for (int j = 0; j < 4; ++j) { const int rr = mt * 16 + (lane >> 4) * 4 + j, cc = ntile * 16 + (lane & 15); WL[rr * 64 + cc] = cw_[j]; AL[rr * 64 + cc] = ca_[j]; } }
        __syncthreads();
        f32x4 r4, v4, kd4, a4, b4;
        { const f32x4 wl = *(const LAS f32x4*)(WL + pi * 64 + pc), al = *(const LAS f32x4*)(AL + pi * 64 + pc);
          r4 = (f32x4){bflo(pr.x), bfhi(pr.x), bflo(pr.y), bfhi(pr.y)}; const f32x4 k4 = {bflo(pk_.x), bfhi(pk_.x), bflo(pk_.y), bfhi(pk_.y)}; v4 = (f32x4){bflo(pv.x), bfhi(pv.x), bflo(pv.y), bfhi(pv.y)};
          f32x4 lw, ic, kk4;
          float ss = 0.f, bp = 0.f;
#pragma unroll
          for (int e = 0; e < 4; ++e) { const float sg = sigmoidf_(w0v[e] + wl[e]); lw[e] = -0.6065306597126334f * sg; ic[e] = sigmoidf_(a0v[e] + al[e]);
              kk4[e] = k4[e] * kkv[e]; ss += kk4[e] * kk4[e]; kd4[e] = k4[e] * (1.f + (ic[e] - 1.f) * kav[e]); bp += r4[e] * kd4[e] * rkv[e]; }
          ss = red16(ss); bp = red16(bp);
          const float inv = 1.f / fmaxf(sqrtf(ss), 1e-12f);
#pragma unroll
          for (int e = 0; e < 4; ++e) { const float kn = kk4[e] * inv; a4[e] = -kn; b4[e] = kn * ic[e]; }
          *(LAS f32x4*)(Wd + pi * 64 + pc) = lw;
          if ((tid & 15) == 0) BON[(size_t)SCAN_TOK(c, pi) * 8 + h] = bp; }
        __syncthreads();
        if (tid < 64) { float vals[32];
#pragma unroll
            for (int t = 0; t < 32; ++t) vals[t] = Wd[t * 64 + tid];
            float acc_ = 0.f;
#pragma unroll
            for (int t = 0; t < 32; ++t) { acc_ += vals[t]; Wd[t * 64 + tid] = acc_; } }
        __syncthreads();
        { const f32x4 Lt = *(const LAS f32x4*)(Wd + pi * 64 + pc); f32x4 Lp = {0.f, 0.f, 0.f, 0.f}; if (pi > 0) Lp = *(const LAS f32x4*)(Wd + (pi - 1) * 64 + pc);
          f32x4 at, bt, kt, rt, et;
#pragma unroll
          for (int e = 0; e < 4; ++e) { const float ep = __expf(Lp[e]); et[e] = __expf(Lt[e]); const float eti = __builtin_amdgcn_rcpf(et[e]);
              at[e] = a4[e] * ep; bt[e] = b4[e] * eti; kt[e] = kd4[e] * eti; rt[e] = r4[e] * et[e]; }
          *(LAS f32x4*)(Aa + pi * 64 + pc) = at; *(LAS f32x4*)(Bb + pi * 64 + pc) = bt;
          *(LAS f32x4*)(Kd + pi * 64 + pc) = kt; *(LAS f32x4*)(Rr + pi * 64 + pc) = rt; *(LAS f32x4*)(Vv + pi * 64 + pc) = v4;
          if (pi == 31) *(LAS f32x4*)(Sx + pc) = et; }
        __syncthreads();
        if (c + 1 < nch) SCAN_LOAD(c + 1);
        float ykq = 0.f;
#define LO2(v) __builtin_shufflevector(v, v, 0, 1)
#define HI2(v) __builtin_shufflevector(v, v, 2, 3)
#define RED3(x, z) do { x += DPPF(x, 0xB1); z += DPPF(z, 0xB1); x += DPPF(x, 0x4E); z += DPPF(z, 0x4E); x += DPPF(x, 0x141); z += DPPF(z, 0x141); } while (0)
#pragma unroll 1
        for (int q = 0; q < 16; ++q) {
            f32x2 a2_[2][4], b2_[2][4], k2_[2][4], r2_[2][4]; float vvs[2];
#pragma unroll
            for (int ii = 0; ii < 2; ++ii) { const int i = 2 * q + ii;
                const f32x4 a_0 = *(const LAS f32x4*)(Aa + i * 64 + 8 * cgp), a_1 = *(const LAS f32x4*)(Aa + i * 64 + 8 * cgp + 4);
                const f32x4 b_0 = *(const LAS f32x4*)(Bb + i * 64 + 8 * cgp), b_1 = *(const LAS f32x4*)(Bb + i * 64 + 8 * cgp + 4);
                const f32x4 k_0 = *(const LAS f32x4*)(Kd + i * 64 + 8 * cgp), k_1 = *(const LAS f32x4*)(Kd + i * 64 + 8 * cgp + 4);
                const f32x4 r_0 = *(const LAS f32x4*)(Rr + i * 64 + 8 * cgp), r_1 = *(const LAS f32x4*)(Rr + i * 64 + 8 * cgp + 4);
                vvs[ii] = Vv[i * 64 + row];
                a2_[ii][0] = LO2(a_0); a2_[ii][1] = HI2(a_0); a2_[ii][2] = LO2(a_1); a2_[ii][3] = HI2(a_1);
                b2_[ii][0] = LO2(b_0); b2_[ii][1] = HI2(b_0); b2_[ii][2] = LO2(b_1); b2_[ii][3] = HI2(b_1);
                k2_[ii][0] = LO2(k_0); k2_[ii][1] = HI2(k_0); k2_[ii][2] = LO2(k_1); k2_[ii][3] = HI2(k_1);
                r2_[ii][0] = LO2(r_0); r2_[ii][1] = HI2(r_0); r2_[ii][2] = LO2(r_1); r2_[ii][3] = HI2(r_1); }
            f32x2 s2 = st2[0] * a2_[0][0], p2 = sp2[0] * a2_[0][0];
#pragma unroll
            for (int j = 1; j < 4; ++j) { s2 = st2[j] * a2_[0][j] + s2; if (WITH_P) p2 = sp2[j] * a2_[0][j] + p2; }
            float sa = s2.x + s2.y, pa = p2.x + p2.y;
            RED3(sa, pa);
            { const f32x2 sab = {sa, sa}, vvb = {vvs[0], vvs[0]}, pab = {pa, pa};
#pragma unroll
              for (int j = 0; j < 4; ++j) { st2[j] = vvb * k2_[0][j] + st2[j]; st2[j] = sab * b2_[0][j] + st2[j]; if (WITH_P) sp2[j] = pab * b2_[0][j] + sp2[j]; } }
            f32x2 y2 = st2[0] * r2_[0][0]; s2 = st2[0] * a2_[1][0]; p2 = sp2[0] * a2_[1][0];
#pragma unroll
            for (int j = 1; j < 4; ++j) { if (WITH_Y) y2 = st2[j] * r2_[0][j] + y2; s2 = st2[j] * a2_[1][j] + s2; if (WITH_P) p2 = sp2[j] * a2_[1][j] + p2; }
            float y0 = y2.x + y2.y; sa = s2.x + s2.y; pa = p2.x + p2.y;
            RED3(sa, pa);
            if (WITH_Y) { y0 += DPPF(y0, 0xB1); y0 += DPPF(y0, 0x4E); y0 += DPPF(y0, 0x141); if (cgp == ((2 * q) & 7)) ykq = y0; }
            { const f32x2 sab = {sa, sa}, vvb = {vvs[1], vvs[1]}, pab = {pa, pa};
#pragma unroll
              for (int j = 0; j < 4; ++j) { st2[j] = vvb * k2_[1][j] + st2[j]; st2[j] = sab * b2_[1][j] + st2[j]; if (WITH_P) sp2[j] = pab * b2_[1][j] + sp2[j]; } }
            if (WITH_Y) { f32x2 z2 = st2[0] * r2_[1][0];
#pragma unroll
                for (int j = 1; j < 4; ++j) z2 = st2[j] * r2_[1][j] + z2;
                float y1 = z2.x + z2.y; y1 += DPPF(y1, 0xB1); y1 += DPPF(y1, 0x4E); y1 += DPPF(y1, 0x141);
                if (cgp == ((2 * q + 1) & 7)) ykq = y1;
                if ((q & 3) == 3) Yb[(8 * (q >> 2) + cgp) * 64 + row] = ykq; }
        }
        { const f32x4 we0 = *(const LAS f32x4*)(Sx + 8 * cgp), we1 = *(const LAS f32x4*)(Sx + 8 * cgp + 4);
          const f32x2 we2[4] = {LO2(we0), HI2(we0), LO2(we1), HI2(we1)};
#pragma unroll
          for (int j = 0; j < 4; ++j) { st2[j] = st2[j] * we2[j]; if (WITH_P) sp2[j] = sp2[j] * we2[j]; } }
        if (WITH_Y) {
            __syncthreads();
            { const f32x4 y4 = *(const LAS f32x4*)(Yb + pi * 64 + pc); u32x2 w; w.x = cvtpk(y4[0], y4[1]); w.y = cvtpk(y4[2], y4[3]);
              *(u32x2*)(YD + (size_t)SCAN_TOK(c, pi) * 512 + h * 64 + pc) = w; }
        }
    }
#undef SCAN_TOK
#undef SCAN_LOAD
    if (STORE_E) {
        float* eo = EST + ((size_t)(u * 8 + seg) * 64 + row) * 64 + 8 * cgp;
        *(f32x4*)eo = (f32x4){st2[0].x, st2[0].y, st2[1].x, st2[1].y}; *(f32x4*)(eo + 4) = (f32x4){st2[2].x, st2[2].y, st2[3].x, st2[3].y};
    }
    if (WITH_P) {
        float* po = PST + ((size_t)(u * 8 + seg) * 64 + row) * 64 + 8 * cgp;
        *(f32x4*)po = (f32x4){sp2[0].x, sp2[0].y, sp2[1].x, sp2[1].y}; *(f32x4*)(po + 4) = (f32x4){sp2[2].x, sp2[2].y, sp2[3].x, sp2[3].y};
    }
}

#define XB_TMO      128
#define XB_XCNT(j)  (256  + 64 * (j))
#define XB_XSUB(j)  (1280 + 64 * (j))
#define XB_XGEN(j)  (2304 + 64 * (j))
#define XB_TOP      3328
#define XB_TOPGEN   3392
#define XCD_BAR_WORDS 3456
#define XB_SPIN_CAP (1u << 23)
DI unsigned xb_ld(unsigned* p)              { return __hip_atomic_load(p, __ATOMIC_RELAXED, __HIP_MEMORY_SCOPE_AGENT); }
DI unsigned xb_add(unsigned* p, unsigned v) { return __hip_atomic_fetch_add(p, v, __ATOMIC_RELAXED, __HIP_MEMORY_SCOPE_AGENT); }
DI unsigned xb_xcc_id() { return (unsigned)__builtin_amdgcn_s_getreg((3 << 11) | 20) & 0xFu; }
#define XB_SPIN(cond, bar) do { unsigned _sp = 0; while (cond) { __builtin_amdgcn_s_sleep(1); \
    if ((++_sp & 255u) == 0u) { if (xb_ld(&(bar)[XB_TMO])) break; if (_sp > XB_SPIN_CAP) { atomicAdd(&(bar)[XB_TMO], 1u); break; } } } } while (0)
DI void xcd_barrier_complete(unsigned* bar, unsigned x, unsigned& nloc, unsigned& nx) {
    const unsigned G = gridDim.x;
    unsigned sum, cnt, mine, sp = 0u;
    for (;;) {
        sum = 0u; cnt = 0u; mine = 0u;
#pragma unroll
        for (unsigned j = 0; j < 16; ++j) { const unsigned c = xb_ld(&bar[XB_XCNT(j)]); sum += c; cnt += (c > 0u) ? 1u : 0u; mine = (j == x) ? c : mine; }
        if (sum == G) break;
        __builtin_amdgcn_s_sleep(1);
        if ((++sp & 255u) == 0u) { if (xb_ld(&bar[XB_TMO])) break; if (sp > XB_SPIN_CAP) { atomicAdd(&bar[XB_TMO], 1u); break; } }
    }
    nloc = mine > 0u ? mine : 1u; nx = cnt > 0u ? cnt : 1u;
}
DI void xcd_barrier(unsigned* bar, const unsigned x, volatile LAS unsigned* st) {
    asm volatile("s_waitcnt vmcnt(0)" ::: "memory");
    __syncthreads();
    if (threadIdx.x == 0) {
        __builtin_amdgcn_s_waitcnt(0);
        unsigned nloc = st[0], nx = st[1];
        if (nloc == 0u) { xcd_barrier_complete(bar, x, nloc, nx); st[0] = nloc; st[1] = nx; }
        const unsigned old = xb_add(&bar[XB_XSUB(x)], 1u);
        const unsigned gen = old / nloc;
        if (old + 1u == (gen + 1u) * nloc) {
            __builtin_amdgcn_fence(__ATOMIC_RELEASE, "agent");
            asm volatile("s_waitcnt vmcnt(0)" ::: "memory");
            const unsigned og = xb_add(&bar[XB_TOP], 1u);
            const unsigned tg = og / nx;
            if (og + 1u == (tg + 1u) * nx) xb_add(&bar[XB_TOPGEN], 1u);
            else XB_SPIN(xb_ld(&bar[XB_TOPGEN]) == tg, bar);
            __builtin_amdgcn_fence(__ATOMIC_ACQUIRE, "agent");
            xb_add(&bar[XB_XGEN(x)], 1u);
            asm volatile("s_waitcnt vmcnt(0)" ::: "memory");
        } else {
            XB_SPIN(xb_ld(&bar[XB_XGEN(x)]) == gen, bar);
            __builtin_amdgcn_fence(__ATOMIC_ACQUIRE, "agent");
            asm volatile("s_waitcnt vmcnt(0)" ::: "memory");
        }
    }
    __syncthreads();
}
#define GSYNC() xcd_barrier((unsigned*)(WSB + 4096), xb_xcc_id(), (volatile LAS unsigned*)(lds + LDS_BYTES - 64))
#define PHASE_IDS int tid_l = threadIdx.x; asm volatile("" : "+v"(tid_l)); const int tid = tid_l, lane = tid & 63, wave = __builtin_amdgcn_readfirstlane(tid >> 6), G = gridDim.x, bx = blockIdx.x, gw = bx * 8 + wave, NGW = G * 8, gtid = bx * 512 + tid, NTH = G * 512; (void)lane; (void)gw; (void)NGW; (void)gtid; (void)NTH; (void)wave
__global__ void __launch_bounds__(512, 2) fwd_mega(Args a_unused) {
    extern __shared__ __attribute__((aligned(16))) unsigned char lds_raw[];
    LAS unsigned char* lds = (LAS unsigned char*)lds_raw;
    cg::grid_group grid = cg::this_grid();
    if (threadIdx.x < 16) ((LAS unsigned*)(lds + LDS_BYTES - 64))[threadIdx.x] = 0u;
    __syncthreads();
    REP(0) if (PH(0)) { PHASE_IDS;
        LAS float* scr = (LAS float*)(lds + wave * 16384);
        constexpr int I0 = 16 * 64, I1 = 2 * 16, I2 = 16 * 32, I3 = 16 * 176, I4 = 44 * 32, I5 = 16 * 96, I6 = 16 * 32;
        constexpr int NITEMS = I0 + I1 + I2 + 2 * I3 + 2 * I4 + I5 + I6;
        for (int it = gw; it < NITEMS; it += NGW) {
            int r = it; const int ln = lane & 31;
            if (r < I0) { const int nblk = 64, kb = r / nblk, nb = r % nblk; const int n = 512 + nb * 32 + ln; const int src = n < MIXIN ? n : -1;
                tr_item(getargs()->in[4], MIXIN, 1024, W_IN, 512 + nb * 32, kb * 64, src, lane, scr); continue; } r -= I0;
            if (r < I1) { const int nblk = 16, kb = r / nblk, nb = r % nblk; tr_item(getargs()->in[11], 512, 128, W_G, nb * 32, kb * 64, nb * 32 + ln, lane, scr); continue; } r -= I1;
            if (r < I2) { const int nblk = 32, kb = r / nblk, nb = r % nblk; tr_item(getargs()->in[17], 1024, 1024, W_OUT0, nb * 32, kb * 64, nb * 32 + ln, lane, scr); continue; } r -= I2;
            if (r < 2 * I3) { const int l = r / I3; r -= l * I3; const int nblk = 176, kb = r / nblk, nb = r % nblk; const int n = nb * 32 + ln;
                const int src = (n >> 8) * 128 + (n & 127) + ((n >> 7) & 1) * FF;
                tr_item(getargs()->in[29] + (size_t)l * 1024 * NUP, NUP, 1024, W_UP + (size_t)l * NUP * 1024, nb * 32, kb * 64, src, lane, scr); continue; } r -= 2 * I3;
            if (r < 2 * I4) { const int l = r / I4; r -= l * I4; const int nblk = 32, kb = r / nblk, nb = r % nblk;
                tr_item(getargs()->in[32] + (size_t)l * FF * 1024, 1024, FF, W_DN + (size_t)l * 1024 * FF, nb * 32, kb * 64, nb * 32 + ln, lane, scr); continue; } r -= 2 * I4;
            if (r < I5) { const int nblk = 96, kb = r / nblk, nb = r % nblk; const int n = nb * 32 + ln; int src = n;
                if (n < 2048) { const int p = n & 63; src = (n & ~63) + 32 * ((p >> 2) & 1) + 4 * (p >> 3) + (p & 3); }
                tr_item(getargs()->in[20], 3072, 1024, W_QKV, nb * 32, kb * 64, src, lane, scr); continue; } r -= I5;
            { const int nblk = 32, kb = r / nblk, nb = r % nblk; tr_item(getargs()->in[26], 1024, 1024, W_O, nb * 32, kb * 64, nb * 32 + ln, lane, scr); }
        }
        for (int e = gtid; e < 512 * 1024; e += NTH) { const int k = e >> 9, n = e & 511, cs = n >> 8, g = (n >> 5) & 7, c2 = n & 31;
            const float* wr_ = getargs()->in[4] + (size_t)k * MIXIN + g * 64; float s = 0.f; const int cf = (cs && c2 == 0) ? 32 : c2; const bool use_sin = cs && c2 != 0;
            for (int c = 0; c < 64; ++c) { const float ph = (float)((c * cf) & 63) * (1.f / 64.f); s += wr_[c] * (use_sin ? __builtin_amdgcn_sinf(ph) : __builtin_amdgcn_cosf(ph)); }
            W_IN[(size_t)n * 1024 + k] = f2bf(s); }
        for (int e = gtid; e < 4608 * 512; e += NTH) { const int row = e >> 9, j0 = (e & 511) * 8; const int kp = row < 2304 ? row : row - 2304; float v[8];
#pragma unroll
            for (int jj = 0; jj < 8; ++jj) { const float ph = (float)((kp * (j0 + jj)) & 4095) * (1.f / 4096.f); v[jj] = row < 2304 ? __builtin_amdgcn_cosf(ph) : __builtin_amdgcn_sinf(ph); }
            u32x4 w; w.x = cvtpk(v[0], v[1]); w.y = cvtpk(v[2], v[3]); w.z = cvtpk(v[4], v[5]); w.w = cvtpk(v[6], v[7]);
            *(u32x4*)(DFTM + (size_t)row * 4096 + j0) = w; }
        for (int e = gtid; e < TPR * 32; e += NTH) { const int pos = e >> 5, i = e & 31; const float invf = exp2f(-(float)i * (13.287712379549449f / 32.f));
            double rev = (double)pos * (double)invf * 0.15915494309189535; rev -= floor(rev); const float fr_ = (float)rev;
            ROPEC[e] = __builtin_amdgcn_cosf(fr_); ROPES[e] = __builtin_amdgcn_sinf(fr_); }
        if (bx == 0) for (int w_ = tid; w_ < XCD_BAR_WORDS; w_ += 512) ((unsigned*)(WSB + 4096))[w_] = 0u;
        for (int m = gw; m < T; m += 2 * NGW) row_item2(xin_row(x_prompt, x_sample, m), xin_row(x_prompt, x_sample, m + NGW), nullptr, nullptr, nullptr, nullptr, nullptr, getargs()->in[2], HN + (size_t)m * DM, HN + (size_t)(m + NGW) * DM, lane);
    }
    grid.sync();
    if (threadIdx.x == 0) (void)xb_add(&((unsigned*)(WSB + 4096))[XB_XCNT(xb_xcc_id())], 1u);

#ifdef EXTRASYNC
    for (int es_ = 0; es_ < 20; ++es_) GSYNC();
#endif
    REP(1) if (PH(1)) { PHASE_IDS;
        pg8::Gemm g{HN - DM, W_IN, 1024, 1024, 1024};
        pg8::Sched S; S.init(199, 10, G, bx, (size_t)248 * 2048, (size_t)256 * 2048, 1 << 20, 0);
        pg8::EpiIn E{getargs()->in[5], getargs()->in[6], UTS, UTP, RKV, LDB};
        pg8::gemm_phase<pg8::EpiIn, 1>(lds, g, S, E);
    }
    GSYNC();

    REP(2) if (PH(2)) { PHASE_IDS;
#pragma unroll 1
        for (int gi = 0; gi < 2; ++gi) {
            const bf16_t* Ap = gi == 1 ? (const bf16_t*)(LDB + 256) : (const bf16_t*)DFTM;
            const bf16_t* Bp = gi == 0 ? (const bf16_t*)UTS : (const bf16_t*)W_G;
            const int Kk = gi == 1 ? 128 : 4096, lda = gi == 1 ? 384 : 4096, ldb = Kk;
            const int nM = gi == 1 ? 192 : 216, nN = 2, tpb = gi == 1 ? (1 << 20) : 18;
            const size_t bb = gi == 1 ? 0 : (size_t)512 * 4096 * 2;
            bf16_t* Op = gi == 0 ? YCS : GATE; const int ldc = 512;
            pg8::Gemm g{Ap, Bp, Kk, lda, ldb}; pg8::Sched S; S.init(nM, nN, G, bx, (size_t)256 * lda * 2, (size_t)256 * ldb * 2, tpb, bb);
            pg8::EpiStore E{Op, ldc, 0, 1.f}; pg8::gemm_phase<pg8::EpiStore, 0>(lds, g, S, E);
        }
    }
    GSYNC();

    REP(3) if (PH(3)) {
        if (blockIdx.x < 240) { int sq, h, d, seg, nseg; const int b_ = blockIdx.x;
            if (b_ < 112) { const int hd = b_ / 7; seg = b_ % 7; sq = 0; h = hd >> 1; d = hd & 1; nseg = 8; }
            else { const int v = b_ - 112; sq = 1 + (v >> 4); h = (v >> 1) & 7; d = v & 1; seg = 0; nseg = 2; }
            if (seg == 0) scan_unit<false, false, true, true>(lds, sq, h, d, seg, nseg); else scan_unit<true, false, false, true>(lds, sq, h, d, seg, nseg); }
        GSYNC();
        if (blockIdx.x < 240) { int sq, h, d, seg, nseg; const int b_ = blockIdx.x;
            if (b_ < 112) { const int hd = b_ / 7; seg = 1 + b_ % 7; sq = 0; h = hd >> 1; d = hd & 1; nseg = 8; }
            else { const int v = b_ - 112; sq = 1 + (v >> 4); h = (v >> 1) & 7; d = v & 1; seg = 1; nseg = 2; }
            scan_unit<false, true, true, false>(lds, sq, h, d, seg, nseg); }
    }
    GSYNC();

    if (PH(4)) { PHASE_IDS;
        { const int c = gtid & 511, g = c >> 6, cc = c & 63;
          const bool mtok = cc > 32; const int ch = mtok ? 64 - cc : cc;
          const float hs = ((ch != 0) && (ch != 32)) ? 1.f : 0.f;
          const int colU = (ch == 32) ? 256 + g * 32 : g * 32 + ch, colS = 256 + g * 32 + ch;
          for (int it0 = gtid; it0 < TPR * 512; it0 += 4 * NTH) {
              unsigned short vcu[4][4], vsu[4][4], vcs[4][4], vss[4][4]; float sKv[4]; int s2pv[4];
#pragma unroll
              for (int q = 0; q < 4; ++q) { const int sp = (it0 + q * NTH) >> 9; const int s2p = mtok ? ((TPR - sp) & (TPR - 1)) : sp; s2pv[q] = s2p;
                  const int k = s2p & 4095; const bool mir = k > 2048; const int kp = mir ? 4096 - k : k; sKv[q] = mir ? -1.f : 1.f;
#pragma unroll
                  for (int s2 = 0; s2 < 4; ++s2) { const bf16_t* bc = YCS + ((size_t)(s2 * 4608 + kp)) * 512; const bf16_t* bs = bc + (size_t)2304 * 512;
                      vcu[q][s2] = bc[colU]; vsu[q][s2] = bs[colU]; vcs[q][s2] = bc[colS]; vss[q][s2] = bs[colS]; } }
#pragma unroll
              for (int q = 0; q < 4; ++q) { const int sp = (it0 + q * NTH) >> 9; float accv = 0.f;
#pragma unroll
                  for (int s2 = 0; s2 < 4; ++s2) { const float ph = (float)((s2 * s2pv[q]) & 16383) * (1.f / 16384.f); const float cph = __builtin_amdgcn_cosf(ph), sph = __builtin_amdgcn_sinf(ph);
                      const float CU = bf2f(vcu[q][s2]), SUc = bf2f(vsu[q][s2]), CUs = hs * bf2f(vcs[q][s2]), SUs = hs * bf2f(vss[q][s2]);
                      accv += cph * (CU - sKv[q] * SUs) + sph * (-CUs - sKv[q] * SUc); }
                  HN[(size_t)sp * DM + c] = f2bf(accv * (1.f / 1024.f)); } }
          for (int it0 = TPR * 512 + gtid; it0 < T * 512; it0 += 8 * NTH) {
              unsigned short vcu[8], vss[8]; float sKv[8];
#pragma unroll
              for (int q = 0; q < 8; ++q) { const int sp = (it0 + q * NTH) >> 9; const int sq = (sp - TPR) >> 12, s1 = sp & 4095; const int k = mtok ? ((SL - s1) & (SL - 1)) : s1;
                  const bool mir = k > 2048; const int kp = mir ? 4096 - k : k; sKv[q] = mir ? -1.f : 1.f;
                  const bf16_t* bc = YCS + ((size_t)((4 + sq) * 4608 + kp)) * 512; vcu[q] = bc[colU]; vss[q] = bc[(size_t)2304 * 512 + colS]; }
#pragma unroll
              for (int q = 0; q < 8; ++q) { const int sp = (it0 + q * NTH) >> 9;
                  HN[(size_t)sp * DM + c] = f2bf((bf2f(vcu[q]) - sKv[q] * hs * bf2f(vss[q])) * (1.f / 512.f)); } }
        }
        for (int it0 = gtid; it0 < T * 8 * 16; it0 += 4 * NTH) { const int h = (it0 >> 4) & 7, c = h * 64 + (it0 & 15) * 4;
            u32x2 yf[4], yb[4], vv[4], gg[4]; float bon[4];
#pragma unroll
            for (int q = 0; q < 4; ++q) { const int t = (it0 + q * NTH) >> 7;
                yf[q] = *(const u32x2*)(YF + (size_t)t * 512 + c); yb[q] = *(const u32x2*)(YB + (size_t)t * 512 + c);
                vv[q] = *(const u32x2*)(RKV + (size_t)t * 1536 + 1024 + c); gg[q] = *(const u32x2*)(GATE + (size_t)t * 512 + c);
                bon[q] = BONUS[(size_t)t * 8 + h] + BONUS[(size_t)T * 8 + (size_t)t * 8 + h]; }
            const f32x4 lg = *(const f32x4*)(getargs()->in[15] + c), lb = *(const f32x4*)(getargs()->in[16] + c);
#pragma unroll
            for (int q = 0; q < 4; ++q) { const int t = (it0 + q * NTH) >> 7;
                f32x4 y = {bflo(yf[q].x) + bflo(yb[q].x), bfhi(yf[q].x) + bfhi(yb[q].x), bflo(yf[q].y) + bflo(yb[q].y), bfhi(yf[q].y) + bfhi(yb[q].y)};
                const float mu = red16((y[0] + y[1]) + (y[2] + y[3])) * (1.f / 64.f);
                y = y - mu; const float var = red16((y[0] * y[0] + y[1] * y[1]) + (y[2] * y[2] + y[3] * y[3])) * (1.f / 64.f);
                const float rs = rsqrtf(var + 64e-5f);
                const f32x4 v4 = {bflo(vv[q].x), bfhi(vv[q].x), bflo(vv[q].y), bfhi(vv[q].y)}, g4 = {bflo(gg[q].x), bfhi(gg[q].x), bflo(gg[q].y), bfhi(gg[q].y)};
                const f32x4 o = (y * rs * lg + lb + bon[q] * v4) * g4;
                u32x2 w; w.x = cvtpk(o[0], o[1]); w.y = cvtpk(o[2], o[3]);
                *(u32x2*)(HN + (size_t)t * DM + 512 + c) = w; } }
    }
    GSYNC();

    if (PH(5)) { PHASE_IDS;
        pg8::Gemm g{HN, W_OUT0, 1024, 1024, 1024}; pg8::Sched S; S.init(192, 4, G, bx, (size_t)256 * 2048, (size_t)256 * 2048, 1 << 20, 0);
        pg8::EpiStore E{RAWB, 1024, 0, 1.f}; pg8::gemm_phase<pg8::EpiStore, 0>(lds, g, S, E);
    }
    GSYNC();
    { PHASE_IDS; for (int m = gw; m < T; m += 2 * NGW) row_item2(xin_row(x_prompt, x_sample, m), xin_row(x_prompt, x_sample, m + NGW), RAWB + (size_t)m * DM, RAWB + (size_t)(m + NGW) * DM, getargs()->in[3], getargs()->out + (size_t)m * DM, getargs()->out + (size_t)(m + NGW) * DM, getargs()->in[27], HN + (size_t)m * DM, HN + (size_t)(m + NGW) * DM, lane); }
    GSYNC();

#pragma unroll 1
    for (int layer = 0; layer < 2; ++layer) {
        if (layer == 1) {
            REP(10) if (PH(10)) { PHASE_IDS; pg8::Gemm g{HN, W_QKV, 1024, 1024, 1024}; pg8::Sched S; S.init(192, 12, G, bx, (size_t)256 * 2048, (size_t)256 * 2048, 1 << 20, 0);
              pg8::EpiQkv E{ROPEC, ROPES, QB}; pg8::gemm_phase<pg8::EpiQkv, 0>(lds, g, S, E); }
            GSYNC();
            REP(11) if (PH(11)) {
                char* alds = (char*)lds_raw;
                for (int un = blockIdx.x; un < 1536; un += gridDim.x) {
                    int qrow0, h, kv0, seq;
                    if (un < 512) { h = un & 7; qrow0 = (un >> 3) * 256; kv0 = 0; seq = TPR; }
                    else { const int v = un - 512; h = v & 7; const int qb = v >> 3; qrow0 = TPR + qb * 256; kv0 = TPR + (qb >> 4) * SL; seq = SL; }
#pragma unroll 1
                    for (int c = 0; c < 2; ++c) {
                        f32x16 o[4]; float l_reg;
                        __syncthreads();
                        att::attn_pass(QB + (size_t)qrow0 * 1024 + h * 128 + c * 64, KB + (size_t)kv0 * 1024 + h * 128 + c * 64, VB + (size_t)kv0 * 1024 + h * 128, seq, alds, o, l_reg);
                        int tid2 = threadIdx.x; asm volatile("" : "+v"(tid2));
                        const int tidq = tid2, laneq = tidq & 63, r32 = laneq & 31, hi = laneq >> 5;
                        float* wsl = (float*)(alds + 2 * att::SHM_V + 2 * att::SHM_K) + (tidq >> 6) * 64;
                        float* tmp = (float*)(WSB + WS_ATMP) + (size_t)blockIdx.x * (64 * 512);
                        if (hi == 0) wsl[r32] = l_reg; asm volatile("s_waitcnt lgkmcnt(0)" ::: "memory");
                        float rli[16];
#pragma unroll
                        for (int r = 0; r < 16; ++r) rli[r] = __builtin_amdgcn_rcpf(wsl[att::crow(r, hi)]);
                        if (c == 0) {
#pragma unroll
                            for (int d0 = 0; d0 < 4; ++d0) { float* tp = tmp + d0 * 8192 + tidq;
#pragma unroll
                                for (int r = 0; r < 16; ++r) tp[r * 512] = o[d0][r] * rli[r];
                                __builtin_amdgcn_sched_barrier(0); }
                        } else {
                            const float l1 = wave_sum(getargs()->in[21][laneq] * getargs()->in[22][laneq]), l2 = wave_sum(getargs()->in[23][laneq] * getargs()->in[24][laneq]);
                            const float lam = __expf(l1) - __expf(l2) + LAMBDA_INIT;
                            float ssq[16];
#pragma unroll
                            for (int r = 0; r < 16; ++r) ssq[r] = 0.f;
#pragma unroll
                            for (int d0 = 0; d0 < 4; ++d0) { const float* tp = tmp + d0 * 8192 + tidq;
#pragma unroll
                                for (int r = 0; r < 16; ++r) { const float v = tp[r * 512] - lam * (o[d0][r] * rli[r]); o[d0][r] = v; ssq[r] += v * v; }
                                __builtin_amdgcn_sched_barrier(0); }
#pragma unroll
                            for (int r = 0; r < 16; ++r) { float s = ssq[r]; s += __shfl_xor(s, 1); s += __shfl_xor(s, 2); s += __shfl_xor(s, 4); s += __shfl_xor(s, 8); s += __shfl_xor(s, 16);
                                ssq[r] = rsqrtf(s * (1.f / 128.f) + 1e-5f) * (1.f - LAMBDA_INIT); }
                            bf16_t* Ow = HN + (size_t)(qrow0 + (tidq >> 6) * 32) * DM + h * 128;
#pragma unroll
                            for (int d0 = 0; d0 < 4; ++d0) { const float gsub = getargs()->in[25][d0 * 32 + r32]; bf16_t* op = Ow + (size_t)(4 * hi) * DM + d0 * 32 + r32;
#pragma unroll
                                for (int r = 0; r < 16; ++r) op[((r & 3) + 8 * (r >> 2)) * DM] = f2bf(o[d0][r] * ssq[r] * gsub);
                                __builtin_amdgcn_sched_barrier(0); }
                        }
                    }
                }
                __syncthreads();
            }
            GSYNC();
            if (PH(12)) { PHASE_IDS; pg8::Gemm g{HN, W_O, 1024, 1024, 1024}; pg8::Sched S; S.init(192, 4, G, bx, (size_t)256 * 2048, (size_t)256 * 2048, 1 << 20, 0);
              pg8::EpiStore E{RAWB, 1024, 0, 1.f}; pg8::gemm_phase<pg8::EpiStore, 0>(lds, g, S, E); }
            GSYNC();
            { PHASE_IDS; for (int m = gw; m < T; m += 2 * NGW) row_item2(getargs()->out + (size_t)m * DM, getargs()->out + (size_t)(m + NGW) * DM, RAWB + (size_t)m * DM, RAWB + (size_t)(m + NGW) * DM, getargs()->in[19], getargs()->out + (size_t)m * DM, getargs()->out + (size_t)(m + NGW) * DM, getargs()->in[27] + DM, HN + (size_t)m * DM, HN + (size_t)(m + NGW) * DM, lane); }
            GSYNC();
        }
        REP(7) if (PH(7)) { PHASE_IDS; pg8::Gemm g{HN - DM, W_UP + (size_t)layer * NUP * 1024, 1024, 1024, 1024}; pg8::Sched S; S.init(199, 22, G, bx, (size_t)248 * 2048, (size_t)256 * 2048, 1 << 20, 0);
          pg8::EpiUp E{getargs()->in[30] + (size_t)layer * 3 * NUP, getargs()->in[31] + (size_t)layer * NUP, ACT}; pg8::gemm_phase<pg8::EpiUp, 1>(lds, g, S, E); }
        GSYNC();
        REP(8) if (PH(8)) { PHASE_IDS; pg8::Gemm g{ACT, W_DN + (size_t)layer * 1024 * FF, FF, FF, FF}; pg8::Sched S; S.init(192, 4, G, bx, (size_t)256 * FF * 2, (size_t)256 * FF * 2, 1 << 20, 0);
          pg8::EpiStore E{HN, 1024, 0, 1.f}; pg8::gemm_phase<pg8::EpiStore, 0>(lds, g, S, E); }
        GSYNC();
        { PHASE_IDS; for (int m = gw; m < T; m += 2 * NGW) row_item2(getargs()->out + (size_t)m * DM, getargs()->out + (size_t)(m + NGW) * DM, HN + (size_t)m * DM, HN + (size_t)(m + NGW) * DM, getargs()->in[28] + layer * DM, getargs()->out + (size_t)m * DM, getargs()->out + (size_t)(m + NGW) * DM, layer == 0 ? getargs()->in[18] : nullptr, HN + (size_t)m * DM, HN + (size_t)(m + NGW) * DM, lane); }
        if (layer == 0) GSYNC();
    }
}

extern "C" void kernel_launch(void* const* d_in, const int* in_sizes, int n_in, void* d_out, int out_size, void* d_ws, size_t ws_size, hipStream_t stream) {
    static int grid = 0;
    if (grid == 0) {
        if (n_in != 33 || out_size != T * DM || ws_size < WS_END) { fprintf(stderr, "kernel_launch: unexpected shapes: n_in %d out %d ws %zu (need %zu)\n", n_in, out_size, ws_size, (size_t)WS_END); grid = -1; return; }
        int dev = 0, cus = 0, per_cu = 0;
        hipGetDevice(&dev); hipDeviceGetAttribute(&cus, hipDeviceAttributeMultiprocessorCount, dev);
        if (hipFuncSetAttribute((const void*)fwd_mega, hipFuncAttributeMaxDynamicSharedMemorySize, LDS_BYTES) != hipSuccess) { fprintf(stderr, "kernel_launch: hipFuncSetAttribute failed\n"); grid = -1; return; }
        hipOccupancyMaxActiveBlocksPerMultiprocessor(&per_cu, (const void*)fwd_mega, 512, LDS_BYTES);
        (void)hipGetLastError();
        if (per_cu < 1) per_cu = 1;
        grid = cus;
        if (grid > NBLK) grid = NBLK;
    }
    if (grid < 0) return;
    Args a{};
    for (int i = 0; i < 33; ++i) a.in[i] = (const float*)d_in[i];
    a.out = (float*)d_out; a.ws = (unsigned char*)d_ws;
    void* args[] = {&a};
    hipError_t e = hipLaunchCooperativeKernel((const void*)fwd_mega, dim3(grid), dim3(512), args, LDS_BYTES, stream);
    if (e != hipSuccess) fprintf(stderr, "kernel_launch: cooperative launch failed: %s (grid %d)\n", hipGetErrorString(e), grid);
}
```

```cpp
#include <hip/hip_runtime.h>
#include <hip/hip_cooperative_groups.h>
#include <cstdio>
#include <cstdint>
namespace cg = cooperative_groups;

#define DI __device__ __forceinline__
#define LAS __attribute__((address_space(3)))
typedef unsigned short bf16_t;
typedef short bf16x8 __attribute__((ext_vector_type(8)));
typedef short s16x4 __attribute__((ext_vector_type(4)));
typedef float f32x2 __attribute__((ext_vector_type(2)));
typedef float f32x4 __attribute__((ext_vector_type(4)));
typedef float f32x16 __attribute__((ext_vector_type(16)));
typedef unsigned u32x2 __attribute__((ext_vector_type(2)));
typedef unsigned u32x4 __attribute__((ext_vector_type(4)));

constexpr int T = 49152, DM = 1024, TPR = 16384, SL = 4096;
constexpr int NIN = 2560;
constexpr int ZR = 1920, MIXIN = 2432;
constexpr int FF = 2816, NUP = 5632;
constexpr int NBLK = 256;
constexpr float LAMBDA_INIT = 0.35550906759f;

constexpr size_t MiB = 1u << 20;
constexpr size_t WS_WIN = 1 * MiB, WS_WG = 7 * MiB, WS_WOUT0 = 8 * MiB, WS_WUP = 10 * MiB, WS_WDN = 32 * MiB, WS_WQKV = 43 * MiB, WS_WO = 49 * MiB;
constexpr size_t WS_ROPE = 51 * MiB, WS_BONUS = 55 * MiB, WS_DFT = 58 * MiB, WS_HNRAW = 122 * MiB, WS_B = 220 * MiB, WS_END = 512 * MiB;
constexpr size_t WS_HN = WS_HNRAW + 256 * 2048;
constexpr size_t WS_RKV = WS_B, WS_LD = WS_B + 144 * MiB, WS_GATE = WS_B + 180 * MiB, WS_YC = WS_B + 228 * MiB;
constexpr size_t WS_RAWB = WS_B, WS_ACT = WS_B, WS_Q = WS_B, WS_K = WS_B + 96 * MiB, WS_V = WS_B + 192 * MiB;
constexpr size_t WS_ATMP = WS_DFT;
constexpr size_t DO_UTS = 0, DO_UTP = 64 * MiB, DO_YF = 0, DO_YB = 48 * MiB, DO_SC = 146 * MiB, DO_SS = 166 * MiB;

constexpr int LDS_BYTES = 147456;
#ifndef PHMASK
#define PHMASK 0xFFFF
#endif
#define PH(k) ((PHMASK >> (k)) & 1)
#ifndef DUPMASK
#define DUPMASK 0
#endif
#define REP(k) for (int rep_ = 0; rep_ < 1 + ((DUPMASK >> (k)) & 1); ++rep_)

struct Args { const float* in[33]; float* out; unsigned char* ws; };

DI unsigned cvtpk(float lo, float hi) { unsigned r; asm volatile("v_cvt_pk_bf16_f32 %0, %1, %2" : "=v"(r) : "v"(lo), "v"(hi)); return r; }
DI unsigned short f2bf(float f) { return (unsigned short)(cvtpk(f, f) & 0xffffu); }
DI float bf2f(unsigned h) { return __uint_as_float(h << 16); }
DI float bflo(unsigned w) { return __uint_as_float(w << 16); }
DI float bfhi(unsigned w) { return __uint_as_float(w & 0xffff0000u); }
DI float dppf(float v, const int ctrl) { return v; }
#define DPPF(v, ctrl) __builtin_bit_cast(float, __builtin_amdgcn_update_dpp(0, __builtin_bit_cast(int, (v)), (ctrl), 0xf, 0xf, true))
DI float red8(float v) { v += DPPF(v, 0xB1); v += DPPF(v, 0x4E); v += DPPF(v, 0x141); return v; }
DI float red16(float v) { v = red8(v); v += DPPF(v, 0x128); return v; }
DI float wave_sum(float v) {
#pragma unroll
    for (int o = 1; o < 64; o <<= 1) v += __shfl_xor(v, o);
    return v;
}
DI float sigmoidf_(float x) { return __builtin_amdgcn_rcpf(1.f + __expf(-x)); }
DI bool is_first(int t) { return t == 0 || (t >= TPR && (t & (SL - 1)) == 0); }
DI bool is_last(int t) { return t == TPR - 1 || (t >= TPR && (t & (SL - 1)) == SL - 1); }
DI int seq_pos(int t) { return t < TPR ? t : (t & (SL - 1)); }
DI const float* xin_row(const float* xp, const float* xs, int t) { return t < TPR ? xp + (size_t)t * DM : xs + (size_t)(t - TPR) * DM; }

namespace pg8 {
constexpr int BM = 256, BK = 64, HALF = 128, HTB = HALF * BK * 2, NXCD = 8, WGM = 8;
DI int lds_byte(int r, int c) { const int st = (r >> 4) * 2 + (c >> 5), rr = r & 15, cc = c & 31, ob = rr * 64 + cc * 2; return st * 1024 + (ob ^ (((ob >> 9) & 1) << 5)); }
DI void stage_rc(int b, int& R, int& C) { const int st = b / 1024, sb = b % 1024, swz = sb ^ (((sb >> 9) & 1) << 5); R = (st >> 1) * 16 + swz / 64; C = (st & 1) * 32 + (swz % 64) / 2; }
DI int perm32(int rho) { const int n = rho >> 4, i = rho & 15; return 8 * (i >> 2) + 4 * n + (i & 3); }

struct Unit { int pm, pn; };
struct Gemm { const bf16_t* A; const bf16_t* Bt; int K, lda, ldb; };

struct Sched {
    int nM, nN, nwg, G, c, tpb; size_t a_tstep, b_tstep, b_batch;
    DI void init(int nM_, int nN_, int G_, int c_, size_t a_tstep_, size_t b_tstep_, int tpb_, size_t b_batch_) {
        nM = nM_; nN = nN_; nwg = nM * nN; G = G_; c = c_; a_tstep = a_tstep_; b_tstep = b_tstep_; tpb = tpb_; b_batch = b_batch_; }
    DI bool next(int i, Unit& u) const {
        const long L = (long)i * G + c; if (L >= nwg) return false;
        int wgid = (int)L; { const int q = nwg / NXCD, r = nwg % NXCD, xcd = wgid % NXCD, off = wgid / NXCD; wgid = (xcd < r ? xcd * (q + 1) : r * (q + 1) + (xcd - r) * q) + off; }
        const int nig = WGM * nN, gid = wgid / nig, fm = gid * WGM, gsz = (nM - fm) < WGM ? (nM - fm) : WGM;
        u.pm = fm + ((wgid % nig) % gsz); u.pn = (wgid % nig) / gsz; return true;
    }
    DI size_t aoff(const Unit& u) const { return (size_t)(u.pm % tpb) * a_tstep; }
    DI size_t boff(const Unit& u) const { return (size_t)(u.pm / tpb) * b_batch + (size_t)u.pn * b_tstep; }
};

template <class Epi, int OVL>
DI void gemm_phase(LAS unsigned char* lds, const Gemm g, const Sched& S, const Epi& E) {
    int tid_ = threadIdx.x; asm volatile("" : "+v"(tid_));
    const int tid = tid_, wid = __builtin_amdgcn_readfirstlane(tid >> 6), lane = tid & 63, wr = wid >> 2, wc = wid & 3, fr = lane & 15, fq = lane >> 4;
    const int K = g.K, nt = K / BK;
    unsigned voffA[2], voffB[2];
#pragma unroll
    for (int i = 0; i < 2; ++i) { int R, C; stage_rc(tid * 16 + i * 8192, R, C); const int Rb = (R & ~31) + perm32(R & 31);
        const int Ra = OVL ? ((R >> 6) * 62 + (R & 63)) : R;
        voffA[i] = (unsigned)(Ra * g.lda + C) * 2u; voffB[i] = (unsigned)(Rb * g.ldb + C) * 2u; }
    const size_t kstep = (size_t)(BK * 2);
    const size_t hstepA = (size_t)(OVL ? 124 : 128) * g.lda * 2, hstepB = (size_t)HALF * g.ldb * 2;
    const unsigned ldsw = (unsigned)wid * 1024u;
    const int aoff = lds_byte(wr * 64 + fr, fq * 8), boff = lds_byte(wc * 32 + fr, fq * 8);
#define PG8_SA(b, h) (((b) * 2 + (h)) * HTB)
#define PG8_SB(b, h) ((4 + (b) * 2 + (h)) * HTB)
#define PG8_STAGE(bufoff, gbase, voff) do { _Pragma("unroll") for (int _i = 0; _i < 2; ++_i) \
        __builtin_amdgcn_global_load_lds((const unsigned*)((const char*)(gbase) + (voff)[_i]), (LAS unsigned*)(lds + (bufoff) + ldsw + _i * 8192), 16, 0, 0); } while (0)
#define PG8_LDA(dst, b, h) do { _Pragma("unroll") for (int m = 0; m < 4; ++m) _Pragma("unroll") for (int k = 0; k < 2; ++k) dst[m][k] = *(const LAS bf16x8*)(lds + PG8_SA(b, h) + aoff + m * 2048 + k * 1024); } while (0)
#define PG8_LDB(dst, b, h) do { _Pragma("unroll") for (int n = 0; n < 2; ++n) _Pragma("unroll") for (int k = 0; k < 2; ++k) dst[n][k] = *(const LAS bf16x8*)(lds + PG8_SB(b, h) + boff + n * 2048 + k * 1024); } while (0)
#define PG8_MMA(ai, bj, At, Bt) do { __builtin_amdgcn_s_setprio(1); _Pragma("unroll") for (int m = 0; m < 4; ++m) _Pragma("unroll") for (int n = 0; n < 2; ++n) _Pragma("unroll") for (int k = 0; k < 2; ++k) \
        acc[ai][bj][m][n] = __builtin_amdgcn_mfma_f32_16x16x32_bf16(Bt[n][k], At[m][k], acc[ai][bj][m][n], 0, 0, 0); __builtin_amdgcn_s_setprio(0); } while (0)
#define PG8_WAIT_V(n) asm volatile("s_waitcnt vmcnt(" #n ")" ::: "memory")
#define PG8_WAIT_L(n) asm volatile("s_waitcnt lgkmcnt(" #n ")" ::: "memory")
#define PG8_BAR __builtin_amdgcn_s_barrier()
#define PG8_SCHED __builtin_amdgcn_sched_barrier(0)
    Unit cur, nxt; int ui = 0;
    if (!S.next(0, cur)) return;
    f32x4 acc[2][2][4][2];
#pragma unroll
    for (int a = 0; a < 2; ++a)
#pragma unroll
        for (int b = 0; b < 2; ++b)
#pragma unroll
            for (int m = 0; m < 4; ++m)
#pragma unroll
                for (int n = 0; n < 2; ++n) acc[a][b][m][n] = (f32x4){0.f, 0.f, 0.f, 0.f};
    bf16x8 At[4][2], B0[2][2], B1[2][2];
    const char* cA = (const char*)g.A + S.aoff(cur); const char* cB = (const char*)g.Bt + S.boff(cur);
    PG8_STAGE(PG8_SB(0, 0), cB, voffB); PG8_STAGE(PG8_SB(0, 1), cB + hstepB, voffB); PG8_STAGE(PG8_SA(0, 0), cA, voffA); PG8_STAGE(PG8_SA(0, 1), cA + hstepA, voffA);
    if (wr == 1) PG8_BAR;
    PG8_WAIT_V(2); PG8_BAR;
    PG8_STAGE(PG8_SB(1, 0), cB + kstep, voffB); PG8_STAGE(PG8_SA(1, 0), cA + kstep, voffA); PG8_STAGE(PG8_SB(1, 1), cB + hstepB + kstep, voffB);
    PG8_WAIT_V(6); PG8_BAR;
    for (;;) {
        const bool has_next = S.next(ui + 1, nxt);
        const char* nA = has_next ? (const char*)g.A + S.aoff(nxt) : cA; const char* nB = has_next ? (const char*)g.Bt + S.boff(nxt) : cB;
        for (int t = 0; t < nt; t += 2) {
            const bool last = (t == nt - 2);
            const char* a1 = cA + (size_t)(t + 1) * kstep;
            const char* a2 = last ? nA : cA + (size_t)(t + 2) * kstep; const char* b2 = last ? nB : cB + (size_t)(t + 2) * kstep;
            const char* a3 = a2 + kstep; const char* b3 = b2 + kstep;
            PG8_LDB(B0, 0, 0); PG8_LDB(B1, 0, 1); PG8_SCHED; PG8_LDA(At, 0, 0); PG8_STAGE(PG8_SA(1, 1), a1 + hstepA, voffA);
            PG8_WAIT_V(8); PG8_WAIT_L(0); PG8_BAR; PG8_MMA(0, 0, At, B0); PG8_MMA(0, 1, At, B1); PG8_BAR; PG8_SCHED;
            PG8_LDA(At, 0, 1); PG8_STAGE(PG8_SB(0, 0), b2, voffB); PG8_STAGE(PG8_SB(0, 1), b2 + hstepB, voffB); PG8_STAGE(PG8_SA(0, 0), a2, voffA);
            PG8_WAIT_V(8); PG8_WAIT_L(0); PG8_BAR; PG8_MMA(1, 0, At, B0); PG8_MMA(1, 1, At, B1); PG8_BAR; PG8_SCHED;
            PG8_LDB(B0, 1, 0); PG8_LDB(B1, 1, 1); PG8_SCHED; PG8_LDA(At, 1, 0); PG8_STAGE(PG8_SA(0, 1), a2 + hstepA, voffA);
            PG8_WAIT_V(8); PG8_WAIT_L(0); PG8_BAR; PG8_MMA(0, 0, At, B0); PG8_MMA(0, 1, At, B1); PG8_BAR; PG8_SCHED;
            PG8_LDA(At, 1, 1); PG8_STAGE(PG8_SB(1, 0), b3, voffB); PG8_STAGE(PG8_SB(1, 1), b3 + hstepB, voffB); PG8_STAGE(PG8_SA(1, 0), a3, voffA);
            PG8_WAIT_V(8); PG8_WAIT_L(0); PG8_BAR; PG8_MMA(1, 0, At, B0); PG8_MMA(1, 1, At, B1); PG8_BAR; PG8_SCHED;
        }
        if (wr == 0) PG8_BAR;
        E(acc, cur, wr, wc, fr, fq);
        if (!has_next) break;
#pragma unroll
        for (int a = 0; a < 2; ++a)
#pragma unroll
            for (int b = 0; b < 2; ++b)
#pragma unroll
                for (int m = 0; m < 4; ++m)
#pragma unroll
                    for (int n = 0; n < 2; ++n) acc[a][b][m][n] = (f32x4){0.f, 0.f, 0.f, 0.f};
        cur = nxt; cA = nA; cB = nB; ++ui;
        if (wr == 1) PG8_BAR;
    }
    PG8_WAIT_V(0);
    PG8_BAR;
#undef PG8_SA
#undef PG8_SB
#undef PG8_STAGE
#undef PG8_LDA
#undef PG8_LDB
#undef PG8_MMA
#undef PG8_WAIT_V
#undef PG8_WAIT_L
#undef PG8_BAR
#undef PG8_SCHED
}

struct EpiStore {
    bf16_t* O; int ldc; int row_off; float scale;
    DI void operator()(const f32x4 (&acc)[2][2][4][2], const Unit& u, int wr, int wc, int fr, int fq) const {
        const int row0 = row_off + u.pm * BM + wr * 64 + fr, col0 = u.pn * BM + wc * 32 + 8 * fq;
#pragma unroll
        for (int ai = 0; ai < 2; ++ai)
#pragma unroll
            for (int m = 0; m < 4; ++m) { bf16_t* rowp = O + (size_t)(row0 + ai * HALF + m * 16) * ldc + col0;
#pragma unroll
                for (int bj = 0; bj < 2; ++bj) { const f32x4 v0 = acc[ai][bj][m][0] * scale, v1 = acc[ai][bj][m][1] * scale;
                    u32x4 w; w.x = cvtpk(v0[0], v0[1]); w.y = cvtpk(v0[2], v0[3]); w.z = cvtpk(v1[0], v1[1]); w.w = cvtpk(v1[2], v1[3]);
                    *(u32x4*)(rowp + bj * HALF) = w; } }
    }
};

DI f32x4 shfl4(f32x4 v, int src) { f32x4 r; r.x = __shfl(v.x, src); r.y = __shfl(v.y, src); r.z = __shfl(v.z, src); r.w = __shfl(v.w, src); return r; }

#define CONV_COL(ACC, AI, BJ, N, Z, CP, CM, CN) do { const f32x4 zero4_ = {0.f, 0.f, 0.f, 0.f}; \
    _Pragma("unroll") for (int m = 0; m < 4; ++m) { const f32x4 cur_ = ACC[AI][BJ][m][N]; \
        const f32x4 su_ = (fr == 15) ? (m > 0 ? ACC[AI][BJ][m > 0 ? m - 1 : 0][N] : zero4_) : cur_; \
        const f32x4 sd_ = (fr == 0) ? (m < 3 ? ACC[AI][BJ][m < 3 ? m + 1 : 3][N] : zero4_) : cur_; \
        f32x4 up_ = shfl4(su_, src_up), dn_ = shfl4(sd_, src_dn); \
        const int t_ = tok0 + 16 * m + fr; \
        if (is_first(t_)) up_ = zero4_; if (is_last(t_)) dn_ = zero4_; \
        Z[m] = CP * up_ + CM * cur_ + CN * dn_; } } while (0)
#define CONV_ONE(ACC, AI, BJ, N, M, Z, CP, CM, CN) do { const f32x4 zero4_ = {0.f, 0.f, 0.f, 0.f}; const f32x4 cur_ = ACC[AI][BJ][M][N]; \
        const f32x4 su_ = (fr == 15) ? (M > 0 ? ACC[AI][BJ][M > 0 ? M - 1 : 0][N] : zero4_) : cur_; \
        const f32x4 sd_ = (fr == 0) ? (M < 3 ? ACC[AI][BJ][M < 3 ? M + 1 : 3][N] : zero4_) : cur_; \
        f32x4 up_ = shfl4(su_, src_up), dn_ = shfl4(sd_, src_dn); \
        const int t_ = tok0 + 16 * M + fr; \
        if (is_first(t_)) up_ = zero4_; if (is_last(t_)) dn_ = zero4_; \
        Z = CP * up_ + CM * cur_ + CN * dn_; } while (0)
#define ROW_VALID(m) ((16 * (m) + fr >= 1) && (16 * (m) + fr <= 62) && (tok0 + 16 * (m) + fr < T))

struct EpiIn {
    const float* mu_prev; const float* mu_next; bf16_t* UTS_; bf16_t* UTP_; bf16_t* RKV_; bf16_t* LD_;
    DI void operator()(const f32x4 (&acc)[2][2][4][2], const Unit& u, int wr, int wc, int fr_, int fq_) const {
        int fr = fr_, fq = fq_; asm volatile("" : "+v"(fr), "+v"(fq));
        const int lane = fr | (fq << 4);
        const int src_up = (lane & 48) | ((fr + 15) & 15), src_dn = (lane & 48) | ((fr + 1) & 15);
        if (u.pn < 2) {
#pragma unroll
            for (int ai = 0; ai < 2; ++ai) {
                const int tok0 = u.pm * 248 + (2 * ai + wr) * 62 - 1;
#pragma unroll
                for (int m = 0; m < 4; ++m) {
                    if (ROW_VALID(m)) { const int t = tok0 + 16 * m + fr; const bool smp = t >= TPR;
                        const int s_ = smp ? (t & (SL - 1)) : (t >> 2); const int rb = (smp ? 4 + ((t - TPR) >> 12) : (t & 3)) * 512;
#pragma unroll
                        for (int bj = 0; bj < 2; ++bj) { const int c0 = u.pn * BM + bj * HALF + wc * 32 + 8 * fq;
#pragma unroll
                            for (int n = 0; n < 2; ++n)
#pragma unroll
                                for (int e = 0; e < 4; ++e) UTS_[((size_t)(rb + c0 + 4 * n + e)) * 4096 + s_] = f2bf(acc[ai][bj][m][n][e]); }
                    }
                    __builtin_amdgcn_sched_barrier(0); }
            }
        } else {
#pragma unroll
            for (int bj = 0; bj < 2; ++bj) {
                const int zc0 = u.pn * BM + bj * HALF + wc * 32 + 8 * fq - 512;
                if (zc0 >= ZR) continue;
                const int act = zc0 < 1536 ? 0 : (zc0 < 1664 ? 1 : (zc0 < 1792 ? 0 : 2));
#pragma unroll
                for (int n = 0; n < 2; ++n) { const f32x4 cp = *(const f32x4*)(mu_prev + zc0 + 4 * n), cn = *(const f32x4*)(mu_next + zc0 + 4 * n); const f32x4 cm = 1.f - cp - cn;
#pragma unroll
                    for (int ai = 0; ai < 2; ++ai) {
                        const int tok0 = u.pm * 248 + (2 * ai + wr) * 62 - 1;
#pragma unroll
                        for (int m = 0; m < 4; ++m) { f32x4 z;
                            CONV_ONE(acc, ai, bj, n, m, z, cp, cm, cn);
                            if (act == 1) {
#pragma unroll
                                for (int e = 0; e < 4; ++e) z[e] = 1.f - 2.f * __builtin_amdgcn_rcpf(1.f + __expf(2.f * z[e])); }
                            if (act == 2) {
#pragma unroll
                                for (int e = 0; e < 4; ++e) z[e] = sigmoidf_(z[e]); }
                            if (ROW_VALID(m)) { const int t = tok0 + 16 * m + fr; u32x2 w; w.x = cvtpk(z[0], z[1]); w.y = cvtpk(z[2], z[3]);
                                if (zc0 < 1536) *(u32x2*)(RKV_ + (size_t)t * 1536 + zc0 + 4 * n) = w; else *(u32x2*)(LD_ + (size_t)t * 384 + (zc0 - 1536) + 4 * n) = w; }
                            __builtin_amdgcn_sched_barrier(0); }
                    }
                }
            }
        }
    }
};

struct EpiUp {
    const float* cw; const float* cb; bf16_t* ACT;
    DI void operator()(const f32x4 (&acc)[2][2][4][2], const Unit& u, int wr, int wc, int fr_, int fq_) const {
        int fr = fr_, fq = fq_; asm volatile("" : "+v"(fr), "+v"(fq));
        const int lane = fr | (fq << 4);
        const int src_up = (lane & 48) | ((fr + 15) & 15), src_dn = (lane & 48) | ((fr + 1) & 15);
        const int cv0 = u.pn * 128 + wc * 32 + 8 * fq;
#pragma unroll
        for (int n = 0; n < 2; ++n) {
            const int sv = cv0 + 4 * n, sg = FF + cv0 + 4 * n;
            const f32x4 vp = *(const f32x4*)(cw + sv), vm = *(const f32x4*)(cw + NUP + sv), vn = *(const f32x4*)(cw + 2 * NUP + sv), vb = *(const f32x4*)(cb + sv);
            const f32x4 gp = *(const f32x4*)(cw + sg), gm = *(const f32x4*)(cw + NUP + sg), gn = *(const f32x4*)(cw + 2 * NUP + sg), gb = *(const f32x4*)(cb + sg);
#pragma unroll
            for (int ai = 0; ai < 2; ++ai) {
                const int tok0 = u.pm * 248 + (2 * ai + wr) * 62 - 1;
#pragma unroll
                for (int m = 0; m < 4; ++m) { f32x4 zv, zg;
                    CONV_ONE(acc, ai, 0, n, m, zv, vp, vm, vn); CONV_ONE(acc, ai, 1, n, m, zg, gp, gm, gn);
                    zv = zv + vb; zg = zg + gb;
                    float ov[4];
#pragma unroll
                    for (int e = 0; e < 4; ++e) { const float x = zg[e]; const float uu = 1.5957691216f * (x + 0.044715f * x * x * x);
                        ov[e] = zv[e] * x * __builtin_amdgcn_rcpf(1.f + __expf(-uu)); }
                    if (ROW_VALID(m)) { const int t = tok0 + 16 * m + fr; u32x2 w; w.x = cvtpk(ov[0], ov[1]); w.y = cvtpk(ov[2], ov[3]);
                        *(u32x2*)(ACT + (size_t)t * FF + cv0 + 4 * n) = w; }
                    __builtin_amdgcn_sched_barrier(0); }
            }
        }
    }
};

struct EpiQkv {
    const float* ropec; const float* ropes; bf16_t* Q;
    DI void operator()(const f32x4 (&acc)[2][2][4][2], const Unit& u, int wr, int wc, int fr_, int fq_) const {
        int fr = fr_, fq = fq_; asm volatile("" : "+v"(fr), "+v"(fq));
        const int which = u.pn >> 2;
        bf16_t* base = Q + (size_t)which * ((size_t)T * 1024);
        const int i0 = 16 * (wc & 1) + 4 * fq;
#pragma unroll
        for (int ai = 0; ai < 2; ++ai)
#pragma unroll
            for (int m = 0; m < 4; ++m) { const int t = u.pm * BM + ai * HALF + wr * 64 + m * 16 + fr;
                f32x4 c4 = (f32x4){1.f, 1.f, 1.f, 1.f}, s4 = (f32x4){0.f, 0.f, 0.f, 0.f};
                if (which < 2) { const int pos = seq_pos(t); c4 = *(const f32x4*)(ropec + pos * 32 + i0); s4 = *(const f32x4*)(ropes + pos * 32 + i0); }
#pragma unroll
                for (int bj = 0; bj < 2; ++bj) { const f32x4 x1 = acc[ai][bj][m][0], x2 = acc[ai][bj][m][1];
                    f32x4 y1 = x1, y2 = x2;
                    if (which < 2) { y1 = x1 * c4 - x2 * s4; y2 = x2 * c4 + x1 * s4; }
                    if (which == 0) { y1 = y1 * (0.125f * 1.4426950408889634f); y2 = y2 * (0.125f * 1.4426950408889634f); }
                    u32x4 w; w.x = cvtpk(y1[0], y1[1]); w.y = cvtpk(y1[2], y1[3]); w.z = cvtpk(y2[0], y2[1]); w.w = cvtpk(y2[2], y2[3]);
                    *(u32x4*)(base + (size_t)t * 1024 + (u.pn & 3) * BM + bj * HALF + wc * 32 + 8 * fq) = w; } }
    }
};
}

namespace att {
constexpr int NW = 8, QBLK = 32, KVBLK = 64, LDQ = 1024;
constexpr float SCALE = 0.125f, THR = 8.f;
constexpr int SHM_V = KVBLK * 128 * 2, SHM_K = KVBLK * 64 * 2;
#define KSWZ(row, colB) ((row) * 128 + ((colB) ^ ((((row) >> 1) & 7) << 4)))
#define SBAR() __builtin_amdgcn_sched_barrier(0)
DI int crow(int r, int hi) { return (r & 3) + 8 * (r >> 2) + 4 * hi; }
DI void partialSM(f32x16& p0, f32x16& p1, float& m_reg, f32x16& negm, float& alpha) {
    constexpr float THR2 = THR * 1.4426950408889634f;
    float pmax = p0[0];
#pragma unroll
    for (int r = 1; r < 16; ++r) pmax = fmaxf(pmax, p0[r]);
#pragma unroll
    for (int r = 0; r < 16; ++r) pmax = fmaxf(pmax, p1[r]);
    { auto rr = __builtin_amdgcn_permlane32_swap(__float_as_uint(pmax), __float_as_uint(pmax), false, false);
      pmax = fmaxf(__uint_as_float(rr[0]), __uint_as_float(rr[1])); }
    const bool first = m_reg < -1e29f;
    if (__builtin_expect(__all(!first && pmax <= THR2), 1)) { alpha = 1.f; }
    else {
        const float d = first ? pmax : fmaxf(pmax, 0.f);
        alpha = first ? 0.f : __builtin_amdgcn_exp2f(-d);
        m_reg = first ? pmax : m_reg + d;
#pragma unroll
        for (int r = 0; r < 16; ++r) { p0[r] -= d; p1[r] -= d; negm[r] = -m_reg; }
    }
#pragma unroll
    for (int r = 0; r < 16; ++r) p0[r] = __builtin_amdgcn_exp2f(p0[r]);
}
DI void finishSM(f32x16& p0, f32x16& p1, float alpha, float& l_reg, bf16x8& pa0, bf16x8& pa1, bf16x8& pa2, bf16x8& pa3) {
#pragma unroll
    for (int r = 0; r < 16; ++r) p1[r] = __builtin_amdgcn_exp2f(p1[r]);
    float ps = 0;
#pragma unroll
    for (int r = 0; r < 16; ++r) ps += p0[r];
#pragma unroll
    for (int r = 0; r < 16; ++r) ps += p1[r];
    { auto rr = __builtin_amdgcn_permlane32_swap(__float_as_uint(ps), __float_as_uint(ps), false, false);
      ps = __uint_as_float(rr[0]) + __uint_as_float(rr[1]); }
    l_reg = l_reg * alpha + ps;
#define PK4(P, BASE, OUT) do { unsigned a0 = cvtpk(P[BASE + 0], P[BASE + 1]), a1 = cvtpk(P[BASE + 2], P[BASE + 3]);   \
    unsigned b0 = cvtpk(P[BASE + 4], P[BASE + 5]), b1 = cvtpk(P[BASE + 6], P[BASE + 7]);                              \
    auto r0 = __builtin_amdgcn_permlane32_swap(a0, b0, false, false); auto r1 = __builtin_amdgcn_permlane32_swap(a1, b1, false, false); \
    u32x4 w = {r0[0], r1[0], r0[1], r1[1]}; OUT = __builtin_bit_cast(bf16x8, w); } while (0)
    PK4(p0, 0, pa0); PK4(p0, 8, pa1); PK4(p1, 0, pa2); PK4(p1, 8, pa3);
#undef PK4
}
DI void qkt(f32x16& p0, f32x16& p1, const char* Ks, const bf16x8* qr, const f32x16& negm, int r32, int hi) {
    { const bf16x8 b0 = *reinterpret_cast<const bf16x8*>(Ks + KSWZ(r32, hi * 16));
      const bf16x8 b1 = *reinterpret_cast<const bf16x8*>(Ks + KSWZ(32 + r32, hi * 16));
      p0 = __builtin_amdgcn_mfma_f32_32x32x16_bf16(b0, qr[0], negm, 0, 0, 0);
      p1 = __builtin_amdgcn_mfma_f32_32x32x16_bf16(b1, qr[0], negm, 0, 0, 0); }
#pragma unroll
    for (int d0 = 1; d0 < 4; ++d0) { const int cb = (d0 * 16 + hi * 8) * 2;
        const bf16x8 b0 = *reinterpret_cast<const bf16x8*>(Ks + KSWZ(r32, cb));
        const bf16x8 b1 = *reinterpret_cast<const bf16x8*>(Ks + KSWZ(32 + r32, cb));
        p0 = __builtin_amdgcn_mfma_f32_32x32x16_bf16(b0, qr[d0], p0, 0, 0, 0);
        p1 = __builtin_amdgcn_mfma_f32_32x32x16_bf16(b1, qr[d0], p1, 0, 0, 0); }
}
DI int v_st(int k, int c) { const int kk = (k & ~0xC) | ((k & 4) << 1) | ((k & 8) >> 1); return ((kk >> 3) * 4 + (c >> 5)) * 512 + ((kk & 7) * 32 + (c & 31)) * 2; }
DI int v_rd_base(int lane) { return ((lane & 3) << 3) | (((lane >> 2) & 3) << 6) | (((lane >> 4) & 1) << 5) | (((lane >> 5) & 1) << 8); }
constexpr int v_rd_off(int d0, int ks, int half) { return d0 * 512 + ks * 4096 + half * 2048; }
template <int OFF> DI s16x4 tr_read(int vb) { s16x4 r; asm volatile("ds_read_b64_tr_b16 %0, %1 offset:%2" : "=&v"(r) : "v"(vb), "i"(OFF) : "memory"); return r; }
template <int D0> DI void pv_one(f32x16& od, int vb, bf16x8 pa0, bf16x8 pa1, bf16x8 pa2, bf16x8 pa3) {
    const s16x4 l0 = tr_read<v_rd_off(D0, 0, 0)>(vb), h0 = tr_read<v_rd_off(D0, 0, 1)>(vb), l1 = tr_read<v_rd_off(D0, 1, 0)>(vb), h1 = tr_read<v_rd_off(D0, 1, 1)>(vb);
    const s16x4 l2 = tr_read<v_rd_off(D0, 2, 0)>(vb), h2 = tr_read<v_rd_off(D0, 2, 1)>(vb), l3 = tr_read<v_rd_off(D0, 3, 0)>(vb), h3 = tr_read<v_rd_off(D0, 3, 1)>(vb);
    asm volatile("s_waitcnt lgkmcnt(0)" ::: "memory"); SBAR();
#define PKV(L, H) (bf16x8){L[0], L[1], L[2], L[3], H[0], H[1], H[2], H[3]}
    od = __builtin_amdgcn_mfma_f32_32x32x16_bf16(pa0, PKV(l0, h0), od, 0, 0, 0);
    od = __builtin_amdgcn_mfma_f32_32x32x16_bf16(pa1, PKV(l1, h1), od, 0, 0, 0);
    od = __builtin_amdgcn_mfma_f32_32x32x16_bf16(pa2, PKV(l2, h2), od, 0, 0, 0);
    od = __builtin_amdgcn_mfma_f32_32x32x16_bf16(pa3, PKV(l3, h3), od, 0, 0, 0);
#undef PKV
}
DI void pv_d0(f32x16* o, int vb, bf16x8 pa0, bf16x8 pa1, bf16x8 pa2, bf16x8 pa3) {
    pv_one<0>(o[0], vb, pa0, pa1, pa2, pa3); pv_one<1>(o[1], vb, pa0, pa1, pa2, pa3); pv_one<2>(o[2], vb, pa0, pa1, pa2, pa3); pv_one<3>(o[3], vb, pa0, pa1, pa2, pa3);
}

DI void attn_pass(const bf16_t* __restrict__ Qb, const bf16_t* __restrict__ Kh, const bf16_t* __restrict__ Vh, int seq, char* lds, f32x16 (&o)[4], float& l_out) {
    int tid_ = threadIdx.x; asm volatile("" : "+v"(tid_));
    const int tid = tid_, wid = tid >> 6, lane = tid & 63, r32 = lane & 31, hi = lane >> 5;
    char* V_lds = lds; char* K_lds = lds + 2 * SHM_V;
    float* ws = (float*)(lds + 2 * SHM_V + 2 * SHM_K) + wid * 64; float* al_l = ws + 32;
    float m_reg = -1e30f, l_reg = 0; bf16x8 qr[4]; f32x16 negm;
#pragma unroll
    for (int r = 0; r < 16; ++r) negm[r] = 0.f;
#pragma unroll
    for (int d = 0; d < 4; ++d)
#pragma unroll
        for (int r = 0; r < 16; ++r) o[d][r] = 0.f;
    const bf16_t* Qw = Qb + (size_t)(wid * QBLK + r32) * LDQ + hi * 8;
#pragma unroll
    for (int d0 = 0; d0 < 4; ++d0) qr[d0] = *reinterpret_cast<const bf16x8*>(Qw + d0 * 16);
    const int sr = tid >> 4, sc = (tid & 15) * 8, vst0 = v_st(sr, sc), vst1 = v_st(32 + sr, sc);
    const int kr = tid >> 3, kc = (tid & 7) * 8, kst = KSWZ(kr, kc * 2);
    const int vb0 = (int)(uintptr_t)V_lds + v_rd_base(lane);
    bf16x8 vsA0, vsA1, ksA, vsB0, vsB1, ksB;
#define SLOADA(k0) do { vsA0 = *reinterpret_cast<const bf16x8*>(&Vh[(size_t)((k0) + sr) * LDQ + sc]); vsA1 = *reinterpret_cast<const bf16x8*>(&Vh[(size_t)((k0) + 32 + sr) * LDQ + sc]); \
    ksA = *reinterpret_cast<const bf16x8*>(&Kh[(size_t)((k0) + kr) * LDQ + kc]); } while (0)
#define SLOADB(k0) do { vsB0 = *reinterpret_cast<const bf16x8*>(&Vh[(size_t)((k0) + sr) * LDQ + sc]); vsB1 = *reinterpret_cast<const bf16x8*>(&Vh[(size_t)((k0) + 32 + sr) * LDQ + sc]); \
    ksB = *reinterpret_cast<const bf16x8*>(&Kh[(size_t)((k0) + kr) * LDQ + kc]); } while (0)
#define SWRITEA(b) do { *(bf16x8*)(V_lds + (b) * SHM_V + vst0) = vsA0; *(bf16x8*)(V_lds + (b) * SHM_V + vst1) = vsA1; *(bf16x8*)(K_lds + (b) * SHM_K + kst) = ksA; } while (0)
#define SWRITEB(b) do { *(bf16x8*)(V_lds + (b) * SHM_V + vst0) = vsB0; *(bf16x8*)(V_lds + (b) * SHM_V + vst1) = vsB1; *(bf16x8*)(K_lds + (b) * SHM_K + kst) = ksB; } while (0)
#define SWAIT() asm volatile("s_waitcnt vmcnt(3)" ::: "memory")
#define RESC(a) do { if (__any((a) < 1.f)) { if (hi == 0) al_l[r32] = (a); asm volatile("s_waitcnt lgkmcnt(0)" ::: "memory"); \
    _Pragma("unroll") for (int d = 0; d < 4; ++d) _Pragma("unroll") for (int r = 0; r < 16; ++r) o[d][r] *= al_l[crow(r, hi)]; } } while (0)
    f32x16 pA0, pA1, pB0, pB1; float alA, alB; bf16x8 pa0, pa1, pa2, pa3; const int NT = seq / KVBLK;
    SLOADA(0); asm volatile("s_waitcnt vmcnt(0)" ::: "memory"); SWRITEA(0); __syncthreads();
    qkt(pA0, pA1, K_lds, qr, negm, r32, hi); partialSM(pA0, pA1, m_reg, negm, alA);
    SLOADB(KVBLK); if (2 < NT) SLOADA(2 * KVBLK);
    SWAIT(); SWRITEB(1); __syncthreads();
    for (int j = 1; j + 1 < NT; j += 2) {
        SBAR(); qkt(pB0, pB1, K_lds + SHM_K, qr, negm, r32, hi);
        finishSM(pA0, pA1, alA, l_reg, pa0, pa1, pa2, pa3); SBAR();
        SLOADB((j + 2) * KVBLK); SBAR();
        pv_d0(o, vb0, pa0, pa1, pa2, pa3); partialSM(pB0, pB1, m_reg, negm, alB);
        __syncthreads(); SWAIT(); SWRITEA(0);
        RESC(alB); __syncthreads();
        SBAR(); qkt(pA0, pA1, K_lds, qr, negm, r32, hi);
        finishSM(pB0, pB1, alB, l_reg, pa0, pa1, pa2, pa3); SBAR();
        if (j + 3 < NT) SLOADA((j + 3) * KVBLK); SBAR();
        pv_d0(o, vb0 + SHM_V, pa0, pa1, pa2, pa3); partialSM(pA0, pA1, m_reg, negm, alA);
        __syncthreads(); if (j + 3 < NT) SWAIT(); else asm volatile("s_waitcnt vmcnt(0)" ::: "memory"); SWRITEB(1);
        RESC(alA); __syncthreads();
    }
    SBAR(); qkt(pB0, pB1, K_lds + SHM_K, qr, negm, r32, hi);
    finishSM(pA0, pA1, alA, l_reg, pa0, pa1, pa2, pa3); SBAR();
    pv_d0(o, vb0, pa0, pa1, pa2, pa3); partialSM(pB0, pB1, m_reg, negm, alB);
    __syncthreads(); RESC(alB);
    finishSM(pB0, pB1, alB, l_reg, pa0, pa1, pa2, pa3); SBAR();
    pv_d0(o, vb0 + SHM_V, pa0, pa1, pa2, pa3);
    l_out = l_reg;
#undef SLOADA
#undef SLOADB
#undef SWRITEA
#undef SWRITEB
#undef SWAIT
#undef RESC
}
}

DI void tr_item(const float* W, int ldw, int K, bf16_t* WT, int n0, int k0, int srccol, int lane, LAS float* scr) {
#pragma unroll 8
    for (int i = 0; i < 32; ++i) { const int kk = 2 * i + (lane >> 5); scr[kk * 33 + (lane & 31)] = srccol >= 0 ? __builtin_nontemporal_load(W + (size_t)(k0 + kk) * ldw + srccol) : 0.f; }
    asm volatile("s_waitcnt lgkmcnt(0)" ::: "memory");
    const int c = lane & 7;
#pragma unroll
    for (int j = 0; j < 4; ++j) { const int n = (lane >> 3) + 8 * j; const LAS float* s = scr + (8 * c) * 33 + n;
        u32x4 o; o.x = cvtpk(s[0 * 33], s[1 * 33]); o.y = cvtpk(s[2 * 33], s[3 * 33]); o.z = cvtpk(s[4 * 33], s[5 * 33]); o.w = cvtpk(s[6 * 33], s[7 * 33]);
        *(u32x4*)(WT + (size_t)(n0 + n) * K + k0 + 8 * c) = o; }
    asm volatile("s_waitcnt lgkmcnt(0)" ::: "memory");
}

DI void row_item(const float* xrow, const bf16_t* hrow, const float* gpost, float* orow, const float* gpre, bf16_t* hnrow, int lane) {
    f32x4 v[4];
#pragma unroll
    for (int j = 0; j < 4; ++j) v[j] = *((const f32x4*)xrow + lane + 64 * j);
    if (hrow) {
        f32x4 h[4]; float s = 0.f;
#pragma unroll
        for (int j = 0; j < 4; ++j) { const u32x2 w = *((const u32x2*)hrow + lane + 64 * j); h[j] = (f32x4){bflo(w.x), bfhi(w.x), bflo(w.y), bfhi(w.y)};
            s += (h[j].x * h[j].x + h[j].y * h[j].y) + (h[j].z * h[j].z + h[j].w * h[j].w); }
        const float rs = rsqrtf(wave_sum(s) * (1.f / DM) + 1e-6f);
#pragma unroll
        for (int j = 0; j < 4; ++j) { const f32x4 g = *((const f32x4*)gpost + lane + 64 * j); v[j] = v[j] + h[j] * rs * g; *((f32x4*)orow + lane + 64 * j) = v[j]; }
    }
    if (gpre) {
        float s = 0.f;
#pragma unroll
        for (int j = 0; j < 4; ++j) s += (v[j].x * v[j].x + v[j].y * v[j].y) + (v[j].z * v[j].z + v[j].w * v[j].w);
        const float rs = rsqrtf(wave_sum(s) * (1.f / DM) + 1e-6f);
#pragma unroll
        for (int j = 0; j < 4; ++j) { const f32x4 g = *((const f32x4*)gpre + lane + 64 * j); const f32x4 y = v[j] * rs * g;
            u32x2 w; w.x = cvtpk(y.x, y.y); w.y = cvtpk(y.z, y.w); *((u32x2*)hnrow + lane + 64 * j) = w; }
    }
}

DI void row_item2(const float* xa, const float* xb, const bf16_t* ha, const bf16_t* hb, const float* gpost, float* oa, float* ob, const float* gpre, bf16_t* hna, bf16_t* hnb, int lane) {
    f32x4 va[4], vb[4]; u32x2 wa[4], wb[4];
#pragma unroll
    for (int j = 0; j < 4; ++j) { va[j] = __builtin_nontemporal_load((const f32x4*)xa + lane + 64 * j); vb[j] = __builtin_nontemporal_load((const f32x4*)xb + lane + 64 * j); }
    if (ha) {
#pragma unroll
        for (int j = 0; j < 4; ++j) { wa[j] = *((const u32x2*)ha + lane + 64 * j); wb[j] = *((const u32x2*)hb + lane + 64 * j); }
        f32x4 h[4]; float s = 0.f;
#pragma unroll
        for (int j = 0; j < 4; ++j) { const u32x2 w = wa[j]; h[j] = (f32x4){bflo(w.x), bfhi(w.x), bflo(w.y), bfhi(w.y)}; s += (h[j].x * h[j].x + h[j].y * h[j].y) + (h[j].z * h[j].z + h[j].w * h[j].w); }
        float rs = rsqrtf(wave_sum(s) * (1.f / DM) + 1e-6f);
#pragma unroll
        for (int j = 0; j < 4; ++j) { const f32x4 g = *((const f32x4*)gpost + lane + 64 * j); va[j] = va[j] + h[j] * rs * g; __builtin_nontemporal_store(va[j], (f32x4*)oa + lane + 64 * j); }
        s = 0.f;
#pragma unroll
        for (int j = 0; j < 4; ++j) { const u32x2 w = wb[j]; h[j] = (f32x4){bflo(w.x), bfhi(w.x), bflo(w.y), bfhi(w.y)}; s += (h[j].x * h[j].x + h[j].y * h[j].y) + (h[j].z * h[j].z + h[j].w * h[j].w); }
        rs = rsqrtf(wave_sum(s) * (1.f / DM) + 1e-6f);
#pragma unroll
        for (int j = 0; j < 4; ++j) { const f32x4 g = *((const f32x4*)gpost + lane + 64 * j); vb[j] = vb[j] + h[j] * rs * g; __builtin_nontemporal_store(vb[j], (f32x4*)ob + lane + 64 * j); }
    }
    if (gpre) {
        float s = 0.f, t = 0.f;
#pragma unroll
        for (int j = 0; j < 4; ++j) { s += (va[j].x * va[j].x + va[j].y * va[j].y) + (va[j].z * va[j].z + va[j].w * va[j].w); t += (vb[j].x * vb[j].x + vb[j].y * vb[j].y) + (vb[j].z * vb[j].z + vb[j].w * vb[j].w); }
        const float rsa = rsqrtf(wave_sum(s) * (1.f / DM) + 1e-6f), rsb = rsqrtf(wave_sum(t) * (1.f / DM) + 1e-6f);
#pragma unroll
        for (int j = 0; j < 4; ++j) { const f32x4 g = *((const f32x4*)gpre + lane + 64 * j); const f32x4 ya = va[j] * rsa * g, yb = vb[j] * rsb * g;
            u32x2 w; w.x = cvtpk(ya.x, ya.y); w.y = cvtpk(ya.z, ya.w); *((u32x2*)hna + lane + 64 * j) = w;
            u32x2 w2; w2.x = cvtpk(yb.x, yb.y); w2.y = cvtpk(yb.z, yb.w); *((u32x2*)hnb + lane + 64 * j) = w2; }
    }
}

typedef const __attribute__((address_space(4))) Args* ArgsP;
DI ArgsP getargs() { unsigned long long kp = (unsigned long long)__builtin_amdgcn_kernarg_segment_ptr(); asm volatile("" : "+s"(kp)); return (ArgsP)kp; }
#define WSB (getargs()->ws)
#define DOB ((unsigned char*)getargs()->out)
#define x_prompt (getargs()->in[0])
#define x_sample (getargs()->in[1])
#define W_IN ((bf16_t*)(WSB + WS_WIN))
#define W_G ((bf16_t*)(WSB + WS_WG))
#define W_OUT0 ((bf16_t*)(WSB + WS_WOUT0))
#define W_UP ((bf16_t*)(WSB + WS_WUP))
#define W_DN ((bf16_t*)(WSB + WS_WDN))
#define W_QKV ((bf16_t*)(WSB + WS_WQKV))
#define W_O ((bf16_t*)(WSB + WS_WO))
#define ROPEC ((float*)(WSB + WS_ROPE))
#define ROPES (ROPEC + TPR * 32)
#define BONUS ((float*)(WSB + WS_BONUS))
#define DFTM ((bf16_t*)(WSB + WS_DFT))
#define HN ((bf16_t*)(WSB + WS_HN))
#define RKV ((bf16_t*)(WSB + WS_RKV))
#define LDB ((bf16_t*)(WSB + WS_LD))
#define GATE ((bf16_t*)(WSB + WS_GATE))
#define YC ((bf16_t*)(WSB + WS_YC))
#define RAWB ((bf16_t*)(WSB + WS_RAWB))
#define ACT ((bf16_t*)(WSB + WS_ACT))
#define QB ((bf16_t*)(WSB + WS_Q))
#define KB ((bf16_t*)(WSB + WS_K))
#define VB ((bf16_t*)(WSB + WS_V))
#define UTS ((bf16_t*)(DOB + DO_UTS))
#define UTP ((bf16_t*)(DOB + DO_UTP))
#define YF ((bf16_t*)(DOB + DO_YF))
#define YB ((bf16_t*)(DOB + DO_YB))
#define YCS ((bf16_t*)(WSB + 448 * MiB))
#define SSB ((bf16_t*)(DOB + DO_SS))

template <bool WITH_P, bool FROM_STATE, bool WITH_Y, bool STORE_E>
DI void scan_unit(LAS unsigned char* lds, const int sq, const int h, const int d, const int seg, const int nseg) {
    int tid_l = threadIdx.x; asm volatile("" : "+v"(tid_l)); const int tid = tid_l, lane = tid & 63, wave = __builtin_amdgcn_readfirstlane(tid >> 6);
    const int s0 = sq == 0 ? 0 : TPR + (sq - 1) * SL, len = sq == 0 ? TPR : SL, seglen = len / nseg, p0 = seg * seglen;
    const int u = sq * 16 + h * 2 + d;
    float* EST = (float*)(DOB + 96 * MiB); float* PST = (float*)(DOB + 128 * MiB);
    LAS float* Wd = (LAS float*)lds; LAS float* Aa = Wd + 2048; LAS float* Bb = Aa + 2048; LAS float* Kd = Bb + 2048; LAS float* Rr = Kd + 2048; LAS float* Vv = Rr + 2048;
    LAS float* WL = Vv + 2048; LAS float* AL = WL + 2048; LAS float* Yb = AL + 2048; LAS float* Sx = Yb + 2048;
    const float* w0 = getargs()->in[7] + d * 512 + h * 64; const float* w2 = getargs()->in[8] + (size_t)d * 64 * 512 + h * 64;
    const float* a0 = getargs()->in[9] + d * 512 + h * 64; const float* a2 = getargs()->in[10] + (size_t)d * 64 * 512 + h * 64;
    const float* kkp = getargs()->in[12] + h * 64; const float* kap = getargs()->in[13] + h * 64; const float* rkp = getargs()->in[14] + h * 64;
    bf16_t* YD = d ? YB : YF; float* BON = BONUS + (size_t)d * T * 8;
    const int mt = wave & 1, ntile = wave >> 1;
    bf16x8 bw[2], ba[2];
#pragma unroll
    for (int ks = 0; ks < 2; ++ks) { float fw[8], fa[8];
#pragma unroll
        for (int j = 0; j < 8; ++j) { const int k = ks * 32 + (lane >> 4) * 8 + j; fw[j] = w2[(size_t)k * 512 + ntile * 16 + (lane & 15)]; fa[j] = a2[(size_t)k * 512 + ntile * 16 + (lane & 15)]; }
        u32x4 pw = {cvtpk(fw[0], fw[1]), cvtpk(fw[2], fw[3]), cvtpk(fw[4], fw[5]), cvtpk(fw[6], fw[7])}; bw[ks] = __builtin_bit_cast(bf16x8, pw);
        u32x4 pa = {cvtpk(fa[0], fa[1]), cvtpk(fa[2], fa[3]), cvtpk(fa[4], fa[5]), cvtpk(fa[6], fa[7])}; ba[ks] = __builtin_bit_cast(bf16x8, pa); }
    const int pi = tid >> 4, pc = (tid & 15) * 4;
    const f32x4 w0v = *(const f32x4*)(w0 + pc), a0v = *(const f32x4*)(a0 + pc), kkv = *(const f32x4*)(kkp + pc), kav = *(const f32x4*)(kap + pc), rkv = *(const f32x4*)(rkp + pc);
    const int rl = lane >> 3, cgp = lane & 7, row = 8 * wave + rl;
    float st[8], sp[8];
#pragma unroll
    for (int j = 0; j < 8; ++j) { st[j] = 0.f; sp[j] = (8 * cgp + j == row) ? 1.f : 0.f; }
    if (FROM_STATE) {
        const float* e0 = EST + ((size_t)(u * 8 + 0) * 64 + row) * 64 + 8 * cgp;
#pragma unroll
        for (int j = 0; j < 8; ++j) st[j] = e0[j];
        for (int i = 1; i < seg; ++i) {
#pragma unroll
            for (int j = 0; j < 8; ++j) Sx[row * 64 + 8 * cgp + j] = st[j];
            __syncthreads();
            const float* ei = EST + ((size_t)(u * 8 + i) * 64 + row) * 64 + 8 * cgp; const float* pp = PST + (size_t)(u * 8 + i) * 4096 + 8 * cgp;
            float ac[8];
#pragma unroll
            for (int j = 0; j < 8; ++j) ac[j] = ei[j];
            for (int k = 0; k < 64; ++k) { const float sk = Sx[row * 64 + k]; const f32x4 q0 = *(const f32x4*)(pp + k * 64), q1 = *(const f32x4*)(pp + k * 64 + 4);
#pragma unroll
                for (int j = 0; j < 4; ++j) { ac[j] += sk * q0[j]; ac[4 + j] += sk * q1[j]; } }
#pragma unroll
            for (int j = 0; j < 8; ++j) st[j] = ac[j];
            __syncthreads();
        }
    }
    f32x2 st2[4], sp2[4];
#pragma unroll
    for (int j = 0; j < 4; ++j) { st2[j] = (f32x2){st[2 * j], st[2 * j + 1]}; sp2[j] = (f32x2){sp[2 * j], sp[2 * j + 1]}; }
    const int nch = seglen / 32;
    u32x2 pr, pk_, pv; bf16x8 fa_w[2], fa_a[2];
#define SCAN_TOK(c, i) (d ? (s0 + len - 1 - (p0 + (c) * 32 + (i))) : (s0 + p0 + (c) * 32 + (i)))
#define SCAN_LOAD(c) do { const int t_ = SCAN_TOK(c, pi); const bf16_t* rp = RKV + (size_t)t_ * 1536 + h * 64 + pc; \
    pr = *(const u32x2*)rp; pk_ = *(const u32x2*)(rp + 512); pv = *(const u32x2*)(rp + 1024); \
    const int ta_ = SCAN_TOK(c, mt * 16 + (lane & 15)); const bf16_t* lp = LDB + (size_t)ta_ * 384 + d * 64 + (lane >> 4) * 8; \
    fa_w[0] = *(const bf16x8*)lp; fa_w[1] = *(const bf16x8*)(lp + 32); fa_a[0] = *(const bf16x8*)(lp + 128); fa_a[1] = *(const bf16x8*)(lp + 160); } while (0)
    SCAN_LOAD(0);
    for (int c = 0; c < nch; ++c) {
        { f32x4 cw_ = {0.f, 0.f, 0.f, 0.f}, ca_ = {0.f, 0.f, 0.f, 0.f};
          cw_ = __builtin_amdgcn_mfma_f32_16x16x32_bf16(fa_w[0], bw[0], cw_, 0, 0, 0); cw_ = __builtin_amdgcn_mfma_f32_16x16x32_bf16(fa_w[1], bw[1], cw_, 0, 0, 0);
          ca_ = __builtin_amdgcn_mfma_f32_16x16x32_bf16(fa_a[0], ba[0], ca_, 0, 0, 0); ca_ = __builtin_amdgcn_mfma_f32_16x16x32_bf16(fa_a[1], ba[1], ca_, 0, 0, 0);
#pragma unroll
          for (int j = 0; j < 4; ++j) { const int rr = mt * 16 + (lane >> 4) * 4 + j, cc = ntile * 16 + (lane & 15); WL[rr * 64 + cc] = cw_[j]; AL[rr * 64 + cc] = ca_[j]; } }
        __syncthreads();
        f32x4 r4, v4, kd4, a4, b4;
        { const f32x4 wl = *(const LAS f32x4*)(WL + pi * 64 + pc), al = *(const LAS f32x4*)(AL + pi * 64 + pc);
          r4 = (f32x4){bflo(pr.x), bfhi(pr.x), bflo(pr.y), bfhi(pr.y)}; const f32x4 k4 = {bflo(pk_.x), bfhi(pk_.x), bflo(pk_.y), bfhi(pk_.y)}; v4 = (f32x4){bflo(pv.x), bfhi(pv.x), bflo(pv.y), bfhi(pv.y)};
          f32x4 lw, ic, kk4;
          float ss = 0.f, bp = 0.f;
#pragma unroll
          for (int e = 0; e < 4; ++e) { const float sg = sigmoidf_(w0v[e] + wl[e]); lw[e] = -0.6065306597126334f * sg; ic[e] = sigmoidf_(a0v[e] + al[e]);
              kk4[e] = k4[e] * kkv[e]; ss += kk4[e] * kk4[e]; kd4[e] = k4[e] * (1.f + (ic[e] - 1.f) * kav[e]); bp += r4[e] * kd4[e] * rkv[e]; }
          ss = red16(ss); bp = red16(bp);
          const float inv = 1.f / fmaxf(sqrtf(ss), 1e-12f);
#pragma unroll
          for (int e = 0; e < 4; ++e) { const float kn = kk4[e] * inv; a4[e] = -kn; b4[e] = kn * ic[e]; }
          *(LAS f32x4*)(Wd + pi * 64 + pc) = lw;
          if ((tid & 15) == 0) BON[(size_t)SCAN_TOK(c, pi) * 8 + h] = bp; }
        __syncthreads();
        if (tid < 64) { float vals[32];
#pragma unroll
            for (int t = 0; t < 32; ++t) vals[t] = Wd[t * 64 + tid];
            float acc_ = 0.f;
#pragma unroll
            for (int t = 0; t < 32; ++t) { acc_ += vals[t]; Wd[t * 64 + tid] = acc_; } }
        __syncthreads();
        { const f32x4 Lt = *(const LAS f32x4*)(Wd + pi * 64 + pc); f32x4 Lp = {0.f, 0.f, 0.f, 0.f}; if (pi > 0) Lp = *(const LAS f32x4*)(Wd + (pi - 1) * 64 + pc);
          f32x4 at, bt, kt, rt, et;
#pragma unroll
          for (int e = 0; e < 4; ++e) { const float ep = __expf(Lp[e]); et[e] = __expf(Lt[e]); const float eti = __builtin_amdgcn_rcpf(et[e]);
              at[e] = a4[e] * ep; bt[e] = b4[e] * eti; kt[e] = kd4[e] * eti; rt[e] = r4[e] * et[e]; }
          *(LAS f32x4*)(Aa + pi * 64 + pc) = at; *(LAS f32x4*)(Bb + pi * 64 + pc) = bt;
          *(LAS f32x4*)(Kd + pi * 64 + pc) = kt; *(LAS f32x4*)(Rr + pi * 64 + pc) = rt; *(LAS f32x4*)(Vv + pi * 64 + pc) = v4;
          if (pi == 31) *(LAS f32x4*)(Sx + pc) = et; }
        __syncthreads();
        if (c + 1 < nch) SCAN_LOAD(c + 1);
        float ykq = 0.f;
#define LO2(v) __builtin_shufflevector(v, v, 0, 1)
#define HI2(v) __builtin_shufflevector(v, v, 2, 3)
#define RED3(x, z) do { x += DPPF(x, 0xB1); z += DPPF(z, 0xB1); x += DPPF(x, 0x4E); z += DPPF(z, 0x4E); x += DPPF(x, 0x141); z += DPPF(z, 0x141); } while (0)
#pragma unroll 1
        for (int q = 0; q < 16; ++q) {
            f32x2 a2_[2][4], b2_[2][4], k2_[2][4], r2_[2][4]; float vvs[2];
#pragma unroll
            for (int ii = 0; ii < 2; ++ii) { const int i = 2 * q + ii;
                const f32x4 a_0 = *(const LAS f32x4*)(Aa + i * 64 + 8 * cgp), a_1 = *(const LAS f32x4*)(Aa + i * 64 + 8 * cgp + 4);
                const f32x4 b_0 = *(const LAS f32x4*)(Bb + i * 64 + 8 * cgp), b_1 = *(const LAS f32x4*)(Bb + i * 64 + 8 * cgp + 4);
                const f32x4 k_0 = *(const LAS f32x4*)(Kd + i * 64 + 8 * cgp), k_1 = *(const LAS f32x4*)(Kd + i * 64 + 8 * cgp + 4);
                const f32x4 r_0 = *(const LAS f32x4*)(Rr + i * 64 + 8 * cgp), r_1 = *(const LAS f32x4*)(Rr + i * 64 + 8 * cgp + 4);
                vvs[ii] = Vv[i * 64 + row];
                a2_[ii][0] = LO2(a_0); a2_[ii][1] = HI2(a_0); a2_[ii][2] = LO2(a_1); a2_[ii][3] = HI2(a_1);
                b2_[ii][0] = LO2(b_0); b2_[ii][1] = HI2(b_0); b2_[ii][2] = LO2(b_1); b2_[ii][3] = HI2(b_1);
                k2_[ii][0] = LO2(k_0); k2_[ii][1] = HI2(k_0); k2_[ii][2] = LO2(k_1); k2_[ii][3] = HI2(k_1);
                r2_[ii][0] = LO2(r_0); r2_[ii][1] = HI2(r_0); r2_[ii][2] = LO2(r_1); r2_[ii][3] = HI2(r_1); }
            f32x2 s2 = st2[0] * a2_[0][0], p2 = sp2[0] * a2_[0][0];
#pragma unroll
            for (int j = 1; j < 4; ++j) { s2 = st2[j] * a2_[0][j] + s2; if (WITH_P) p2 = sp2[j] * a2_[0][j] + p2; }
            float sa = s2.x + s2.y, pa = p2.x + p2.y;
            RED3(sa, pa);
            { const f32x2 sab = {sa, sa}, vvb = {vvs[0], vvs[0]}, pab = {pa, pa};
#pragma unroll
              for (int j = 0; j < 4; ++j) { st2[j] = vvb * k2_[0][j] + st2[j]; st2[j] = sab * b2_[0][j] + st2[j]; if (WITH_P) sp2[j] = pab * b2_[0][j] + sp2[j]; } }
            f32x2 y2 = st2[0] * r2_[0][0]; s2 = st2[0] * a2_[1][0]; p2 = sp2[0] * a2_[1][0];
#pragma unroll
            for (int j = 1; j < 4; ++j) { if (WITH_Y) y2 = st2[j] * r2_[0][j] + y2; s2 = st2[j] * a2_[1][j] + s2; if (WITH_P) p2 = sp2[j] * a2_[1][j] + p2; }
            float y0 = y2.x + y2.y; sa = s2.x + s2.y; pa = p2.x + p2.y;
            RED3(sa, pa);
            if (WITH_Y) { y0 += DPPF(y0, 0xB1); y0 += DPPF(y0, 0x4E); y0 += DPPF(y0, 0x141); if (cgp == ((2 * q) & 7)) ykq = y0; }
            { const f32x2 sab = {sa, sa}, vvb = {vvs[1], vvs[1]}, pab = {pa, pa};
#pragma unroll
              for (int j = 0; j < 4; ++j) { st2[j] = vvb * k2_[1][j] + st2[j]; st2[j] = sab * b2_[1][j] + st2[j]; if (WITH_P) sp2[j] = pab * b2_[1][j] + sp2[j]; } }
            if (WITH_Y) { f32x2 z2 = st2[0] * r2_[1][0];
#pragma unroll
                for (int j = 1; j < 4; ++j) z2 = st2[j] * r2_[1][j] + z2;
                float y1 = z2.x + z2.y; y1 += DPPF(y1, 0xB1); y1 += DPPF(y1, 0x4E); y1 += DPPF(y1, 0x141);
                if (cgp == ((2 * q + 1) & 7)) ykq = y1;
                if ((q & 3) == 3) Yb[(8 * (q >> 2) + cgp) * 64 + row] = ykq; }
        }
        { const f32x4 we0 = *(const LAS f32x4*)(Sx + 8 * cgp), we1 = *(const LAS f32x4*)(Sx + 8 * cgp + 4);
          const f32x2 we2[4] = {LO2(we0), HI2(we0), LO2(we1), HI2(we1)};
#pragma unroll
          for (int j = 0; j < 4; ++j) { st2[j] = st2[j] * we2[j]; if (WITH_P) sp2[j] = sp2[j] * we2[j]; } }
        if (WITH_Y) {
            __syncthreads();
            { const f32x4 y4 = *(const LAS f32x4*)(Yb + pi * 64 + pc); u32x2 w; w.x = cvtpk(y4[0], y4[1]); w.y = cvtpk(y4[2], y4[3]);
              *(u32x2*)(YD + (size_t)SCAN_TOK(c, pi) * 512 + h * 64 + pc) = w; }
        }
    }
#undef SCAN_TOK
#undef SCAN_LOAD
    if (STORE_E) {
        float* eo = EST + ((size_t)(u * 8 + seg) * 64 + row) * 64 + 8 * cgp;
        *(f32x4*)eo = (f32x4){st2[0].x, st2[0].y, st2[1].x, st2[1].y}; *(f32x4*)(eo + 4) = (f32x4){st2[2].x, st2[2].y, st2[3].x, st2[3].y};
    }
    if (WITH_P) {
        float* po = PST + ((size_t)(u * 8 + seg) * 64 + row) * 64 + 8 * cgp;
        *(f32x4*)po = (f32x4){sp2[0].x, sp2[0].y, sp2[1].x, sp2[1].y}; *(f32x4*)(po + 4) = (f32x4){sp2[2].x, sp2[2].y, sp2[3].x, sp2[3].y};
    }
}

#define XB_TMO      128
#define XB_XCNT(j)  (256  + 64 * (j))
#define XB_XSUB(j)  (1280 + 64 * (j))
#define XB_XGEN(j)  (2304 + 64 * (j))
#define XB_TOP      3328
#define XB_TOPGEN   3392
#define XCD_BAR_WORDS 3456
#define XB_SPIN_CAP (1u << 23)
DI unsigned xb_ld(unsigned* p)              { return __hip_atomic_load(p, __ATOMIC_RELAXED, __HIP_MEMORY_SCOPE_AGENT); }
DI unsigned xb_add(unsigned* p, unsigned v) { return __hip_atomic_fetch_add(p, v, __ATOMIC_RELAXED, __HIP_MEMORY_SCOPE_AGENT); }
DI unsigned xb_xcc_id() { return (unsigned)__builtin_amdgcn_s_getreg((3 << 11) | 20) & 0xFu; }
#define XB_SPIN(cond, bar) do { unsigned _sp = 0; while (cond) { __builtin_amdgcn_s_sleep(1); \
    if ((++_sp & 255u) == 0u) { if (xb_ld(&(bar)[XB_TMO])) break; if (_sp > XB_SPIN_CAP) { atomicAdd(&(bar)[XB_TMO], 1u); break; } } } } while (0)
DI void xcd_barrier_complete(unsigned* bar, unsigned x, unsigned& nloc, unsigned& nx) {
    const unsigned G = gridDim.x;
    unsigned sum, cnt, mine, sp = 0u;
    for (;;) {
        sum = 0u; cnt = 0u; mine = 0u;
#pragma unroll
        for (unsigned j = 0; j < 16; ++j) { const unsigned c = xb_ld(&bar[XB_XCNT(j)]); sum += c; cnt += (c > 0u) ? 1u : 0u; mine = (j == x) ? c : mine; }
        if (sum == G) break;
        __builtin_amdgcn_s_sleep(1);
        if ((++sp & 255u) == 0u) { if (xb_ld(&bar[XB_TMO])) break; if (sp > XB_SPIN_CAP) { atomicAdd(&bar[XB_TMO], 1u); break; } }
    }
    nloc = mine > 0u ? mine : 1u; nx = cnt > 0u ? cnt : 1u;
}
DI void xcd_barrier(unsigned* bar, const unsigned x, volatile LAS unsigned* st) {
    asm volatile("s_waitcnt vmcnt(0)" ::: "memory");
    __syncthreads();
    if (threadIdx.x == 0) {
        __builtin_amdgcn_s_waitcnt(0);
        unsigned nloc = st[0], nx = st[1];
        if (nloc == 0u) { xcd_barrier_complete(bar, x, nloc, nx); st[0] = nloc; st[1] = nx; }
        const unsigned old = xb_add(&bar[XB_XSUB(x)], 1u);
        const unsigned gen = old / nloc;
        if (old + 1u == (gen + 1u) * nloc) {
            __builtin_amdgcn_fence(__ATOMIC_RELEASE, "agent");
            asm volatile("s_waitcnt vmcnt(0)" ::: "memory");
            const unsigned og = xb_add(&bar[XB_TOP], 1u);
            const unsigned tg = og / nx;
            if (og + 1u == (tg + 1u) * nx) xb_add(&bar[XB_TOPGEN], 1u);
            else XB_SPIN(xb_ld(&bar[XB_TOPGEN]) == tg, bar);
            __builtin_amdgcn_fence(__ATOMIC_ACQUIRE, "agent");
            xb_add(&bar[XB_XGEN(x)], 1u);
            asm volatile("s_waitcnt vmcnt(0)" ::: "memory");
        } else {
            XB_SPIN(xb_ld(&bar[XB_XGEN(x)]) == gen, bar);
            __builtin_amdgcn_fence(__ATOMIC_ACQUIRE, "agent");
            asm volatile("s_waitcnt vmcnt(0)" ::: "memory");
        }
    }
    __syncthreads();
}
#define GSYNC() xcd_barrier((unsigned*)(WSB + 4096), xb_xcc_id(), (volatile LAS unsigned*)(lds + LDS_BYTES - 64))
#define PHASE_IDS int tid_l = threadIdx.x; asm volatile("" : "+v"(tid_l)); const int tid = tid_l, lane = tid & 63, wave = __builtin_amdgcn_readfirstlane(tid >> 6), G = gridDim.x, bx = blockIdx.x, gw = bx * 8 + wave, NGW = G * 8, gtid = bx * 512 + tid, NTH = G * 512; (void)lane; (void)gw; (void)NGW; (void)gtid; (void)NTH; (void)wave
__global__ void __launch_bounds__(512, 2) fwd_mega(Args a_unused) {
    extern __shared__ __attribute__((aligned(16))) unsigned char lds_raw[];
    LAS unsigned char* lds = (LAS unsigned char*)lds_raw;
    cg::grid_group grid = cg::this_grid();
    if (threadIdx.x < 16) ((LAS unsigned*)(lds + LDS_BYTES - 64))[threadIdx.x] = 0u;
    __syncthreads();
    REP(0) if (PH(0)) { PHASE_IDS;
        LAS float* scr = (LAS float*)(lds + wave * 16384);
        constexpr int I0 = 16 * 64, I1 = 2 * 16, I2 = 16 * 32, I3 = 16 * 176, I4 = 44 * 32, I5 = 16 * 96, I6 = 16 * 32;
        constexpr int NITEMS = I0 + I1 + I2 + 2 * I3 + 2 * I4 + I5 + I6;
        for (int it = gw; it < NITEMS; it += NGW) {
            int r = it; const int ln = lane & 31;
            if (r < I0) { const int nblk = 64, kb = r / nblk, nb = r % nblk; const int n = 512 + nb * 32 + ln; const int src = n < MIXIN ? n : -1;
                tr_item(getargs()->in[4], MIXIN, 1024, W_IN, 512 + nb * 32, kb * 64, src, lane, scr); continue; } r -= I0;
            if (r < I1) { const int nblk = 16, kb = r / nblk, nb = r % nblk; tr_item(getargs()->in[11], 512, 128, W_G, nb * 32, kb * 64, nb * 32 + ln, lane, scr); continue; } r -= I1;
            if (r < I2) { const int nblk = 32, kb = r / nblk, nb = r % nblk; tr_item(getargs()->in[17], 1024, 1024, W_OUT0, nb * 32, kb * 64, nb * 32 + ln, lane, scr); continue; } r -= I2;
            if (r < 2 * I3) { const int l = r / I3; r -= l * I3; const int nblk = 176, kb = r / nblk, nb = r % nblk; const int n = nb * 32 + ln;
                const int src = (n >> 8) * 128 + (n & 127) + ((n >> 7) & 1) * FF;
                tr_item(getargs()->in[29] + (size_t)l * 1024 * NUP, NUP, 1024, W_UP + (size_t)l * NUP * 1024, nb * 32, kb * 64, src, lane, scr); continue; } r -= 2 * I3;
            if (r < 2 * I4) { const int l = r / I4; r -= l * I4; const int nblk = 32, kb = r / nblk, nb = r % nblk;
                tr_item(getargs()->in[32] + (size_t)l * FF * 1024, 1024, FF, W_DN + (size_t)l * 1024 * FF, nb * 32, kb * 64, nb * 32 + ln, lane, scr); continue; } r -= 2 * I4;
            if (r < I5) { const int nblk = 96, kb = r / nblk, nb = r % nblk; const int n = nb * 32 + ln; int src = n;
                if (n < 2048) { const int p = n & 63; src = (n & ~63) + 32 * ((p >> 2) & 1) + 4 * (p >> 3) + (p & 3); }
                tr_item(getargs()->in[20], 3072, 1024, W_QKV, nb * 32, kb * 64, src, lane, scr); continue; } r -= I5;
            { const int nblk = 32, kb = r / nblk, nb = r % nblk; tr_item(getargs()->in[26], 1024, 1024, W_O, nb * 32, kb * 64, nb * 32 + ln, lane, scr); }
        }
        for (int e = gtid; e < 512 * 1024; e += NTH) { const int k = e >> 9, n = e & 511, cs = n >> 8, g = (n >> 5) & 7, c2 = n & 31;
            const float* wr_ = getargs()->in[4] + (size_t)k * MIXIN + g * 64; float s = 0.f; const int cf = (cs && c2 == 0) ? 32 : c2; const bool use_sin = cs && c2 != 0;
            for (int c = 0; c < 64; ++c) { const float ph = (float)((c * cf) & 63) * (1.f / 64.f); s += wr_[c] * (use_sin ? __builtin_amdgcn_sinf(ph) : __builtin_amdgcn_cosf(ph)); }
            W_IN[(size_t)n * 1024 + k] = f2bf(s); }
        for (int e = gtid; e < 4608 * 512; e += NTH) { const int row = e >> 9, j0 = (e & 511) * 8; const int kp = row < 2304 ? row : row - 2304; float v[8];
#pragma unroll
            for (int jj = 0; jj < 8; ++jj) { const float ph = (float)((kp * (j0 + jj)) & 4095) * (1.f / 4096.f); v[jj] = row < 2304 ? __builtin_amdgcn_cosf(ph) : __builtin_amdgcn_sinf(ph); }
            u32x4 w; w.x = cvtpk(v[0], v[1]); w.y = cvtpk(v[2], v[3]); w.z = cvtpk(v[4], v[5]); w.w = cvtpk(v[6], v[7]);
            *(u32x4*)(DFTM + (size_t)row * 4096 + j0) = w; }
        for (int e = gtid; e < TPR * 32; e += NTH) { const int pos = e >> 5, i = e & 31; const float invf = exp2f(-(float)i * (13.287712379549449f / 32.f));
            double rev = (double)pos * (double)invf * 0.15915494309189535; rev -= floor(rev); const float fr_ = (float)rev;
            ROPEC[e] = __builtin_amdgcn_cosf(fr_); ROPES[e] = __builtin_amdgcn_sinf(fr_); }
        if (bx == 0) for (int w_ = tid; w_ < XCD_BAR_WORDS; w_ += 512) ((unsigned*)(WSB + 4096))[w_] = 0u;
        for (int m = gw; m < T; m += 2 * NGW) row_item2(xin_row(x_prompt, x_sample, m), xin_row(x_prompt, x_sample, m + NGW), nullptr, nullptr, nullptr, nullptr, nullptr, getargs()->in[2], HN + (size_t)m * DM, HN + (size_t)(m + NGW) * DM, lane);
    }
    grid.sync();
    if (threadIdx.x == 0) (void)xb_add(&((unsigned*)(WSB + 4096))[XB_XCNT(xb_xcc_id())], 1u);

#ifdef EXTRASYNC
    for (int es_ = 0; es_ < 20; ++es_) GSYNC();
#endif
    REP(1) if (PH(1)) { PHASE_IDS;
        pg8::Gemm g{HN - DM, W_IN, 1024, 1024, 1024};
        pg8::Sched S; S.init(199, 10, G, bx, (size_t)248 * 2048, (size_t)256 * 2048, 1 << 20, 0);
        pg8::EpiIn E{getargs()->in[5], getargs()->in[6], UTS, UTP, RKV, LDB};
        pg8::gemm_phase<pg8::EpiIn, 1>(lds, g, S, E);
    }
    GSYNC();

    REP(2) if (PH(2)) { PHASE_IDS;
#pragma unroll 1
        for (int gi = 0; gi < 2; ++gi) {
            const bf16_t* Ap = gi == 1 ? (const bf16_t*)(LDB + 256) : (const bf16_t*)DFTM;
            const bf16_t* Bp = gi == 0 ? (const bf16_t*)UTS : (const bf16_t*)W_G;
            const int Kk = gi == 1 ? 128 : 4096, lda = gi == 1 ? 384 : 4096, ldb = Kk;
            const int nM = gi == 1 ? 192 : 216, nN = 2, tpb = gi == 1 ? (1 << 20) : 18;
            const size_t bb = gi == 1 ? 0 : (size_t)512 * 4096 * 2;
            bf16_t* Op = gi == 0 ? YCS : GATE; const int ldc = 512;
            pg8::Gemm g{Ap, Bp, Kk, lda, ldb}; pg8::Sched S; S.init(nM, nN, G, bx, (size_t)256 * lda * 2, (size_t)256 * ldb * 2, tpb, bb);
            pg8::EpiStore E{Op, ldc, 0, 1.f}; pg8::gemm_phase<pg8::EpiStore, 0>(lds, g, S, E);
        }
    }
    GSYNC();

    REP(3) if (PH(3)) {
        if (blockIdx.x < 240) { int sq, h, d, seg, nseg; const int b_ = blockIdx.x;
            if (b_ < 112) { const int hd = b_ / 7; seg = b_ % 7; sq = 0; h = hd >> 1; d = hd & 1; nseg = 8; }
            else { const int v = b_ - 112; sq = 1 + (v >> 4); h = (v >> 1) & 7; d = v & 1; seg = 0; nseg = 2; }
            if (seg == 0) scan_unit<false, false, true, true>(lds, sq, h, d, seg, nseg); else scan_unit<true, false, false, true>(lds, sq, h, d, seg, nseg); }
        GSYNC();
        if (blockIdx.x < 240) { int sq, h, d, seg, nseg; const int b_ = blockIdx.x;
            if (b_ < 112) { const int hd = b_ / 7; seg = 1 + b_ % 7; sq = 0; h = hd >> 1; d = hd & 1; nseg = 8; }
            else { const int v = b_ - 112; sq = 1 + (v >> 4); h = (v >> 1) & 7; d = v & 1; seg = 1; nseg = 2; }
            scan_unit<false, true, true, false>(lds, sq, h, d, seg, nseg); }
    }
    GSYNC();

    if (PH(4)) { PHASE_IDS;
        { const int c = gtid & 511, g = c >> 6, cc = c & 63;
          const bool mtok = cc > 32; const int ch = mtok ? 64 - cc : cc;
          const float hs = ((ch != 0) && (ch != 32)) ? 1.f : 0.f;
          const int colU = (ch == 32) ? 256 + g * 32 : g * 32 + ch, colS = 256 + g * 32 + ch;
          for (int it0 = gtid; it0 < TPR * 512; it0 += 4 * NTH) {
              unsigned short vcu[4][4], vsu[4][4], vcs[4][4], vss[4][4]; float sKv[4]; int s2pv[4];
#pragma unroll
              for (int q = 0; q < 4; ++q) { const int sp = (it0 + q * NTH) >> 9; const int s2p = mtok ? ((TPR - sp) & (TPR - 1)) : sp; s2pv[q] = s2p;
                  const int k = s2p & 4095; const bool mir = k > 2048; const int kp = mir ? 4096 - k : k; sKv[q] = mir ? -1.f : 1.f;
#pragma unroll
                  for (int s2 = 0; s2 < 4; ++s2) { const bf16_t* bc = YCS + ((size_t)(s2 * 4608 + kp)) * 512; const bf16_t* bs = bc + (size_t)2304 * 512;
                      vcu[q][s2] = bc[colU]; vsu[q][s2] = bs[colU]; vcs[q][s2] = bc[colS]; vss[q][s2] = bs[colS]; } }
#pragma unroll
              for (int q = 0; q < 4; ++q) { const int sp = (it0 + q * NTH) >> 9; float accv = 0.f;
#pragma unroll
                  for (int s2 = 0; s2 < 4; ++s2) { const float ph = (float)((s2 * s2pv[q]) & 16383) * (1.f / 16384.f); const float cph = __builtin_amdgcn_cosf(ph), sph = __builtin_amdgcn_sinf(ph);
                      const float CU = bf2f(vcu[q][s2]), SUc = bf2f(vsu[q][s2]), CUs = hs * bf2f(vcs[q][s2]), SUs = hs * bf2f(vss[q][s2]);
                      accv += cph * (CU - sKv[q] * SUs) + sph * (-CUs - sKv[q] * SUc); }
                  HN[(size_t)sp * DM + c] = f2bf(accv * (1.f / 1024.f)); } }
          for (int it0 = TPR * 512 + gtid; it0 < T * 512; it0 += 8 * NTH) {
              unsigned short vcu[8], vss[8]; float sKv[8];
#pragma unroll
              for (int q = 0; q < 8; ++q) { const int sp = (it0 + q * NTH) >> 9; const int sq = (sp - TPR) >> 12, s1 = sp & 4095; const int k = mtok ? ((SL - s1) & (SL - 1)) : s1;
                  const bool mir = k > 2048; const int kp = mir ? 4096 - k : k; sKv[q] = mir ? -1.f : 1.f;
                  const bf16_t* bc = YCS + ((size_t)((4 + sq) * 4608 + kp)) * 512; vcu[q] = bc[colU]; vss[q] = bc[(size_t)2304 * 512 + colS]; }
#pragma unroll
              for (int q = 0; q < 8; ++q) { const int sp = (it0 + q * NTH) >> 9;
                  HN[(size_t)sp * DM + c] = f2bf((bf2f(vcu[q]) - sKv[q] * hs * bf2f(vss[q])) * (1.f / 512.f)); } }
        }
        for (int it0 = gtid; it0 < T * 8 * 16; it0 += 4 * NTH) { const int h = (it0 >> 4) & 7, c = h * 64 + (it0 & 15) * 4;
            u32x2 yf[4], yb[4], vv[4], gg[4]; float bon[4];
#pragma unroll
            for (int q = 0; q < 4; ++q) { const int t = (it0 + q * NTH) >> 7;
                yf[q] = *(const u32x2*)(YF + (size_t)t * 512 + c); yb[q] = *(const u32x2*)(YB + (size_t)t * 512 + c);
                vv[q] = *(const u32x2*)(RKV + (size_t)t * 1536 + 1024 + c); gg[q] = *(const u32x2*)(GATE + (size_t)t * 512 + c);
                bon[q] = BONUS[(size_t)t * 8 + h] + BONUS[(size_t)T * 8 + (size_t)t * 8 + h]; }
            const f32x4 lg = *(const f32x4*)(getargs()->in[15] + c), lb = *(const f32x4*)(getargs()->in[16] + c);
#pragma unroll
            for (int q = 0; q < 4; ++q) { const int t = (it0 + q * NTH) >> 7;
                f32x4 y = {bflo(yf[q].x) + bflo(yb[q].x), bfhi(yf[q].x) + bfhi(yb[q].x), bflo(yf[q].y) + bflo(yb[q].y), bfhi(yf[q].y) + bfhi(yb[q].y)};
                const float mu = red16((y[0] + y[1]) + (y[2] + y[3])) * (1.f / 64.f);
                y = y - mu; const float var = red16((y[0] * y[0] + y[1] * y[1]) + (y[2] * y[2] + y[3] * y[3])) * (1.f / 64.f);
                const float rs = rsqrtf(var + 64e-5f);
                const f32x4 v4 = {bflo(vv[q].x), bfhi(vv[q].x), bflo(vv[q].y), bfhi(vv[q].y)}, g4 = {bflo(gg[q].x), bfhi(gg[q].x), bflo(gg[q].y), bfhi(gg[q].y)};
                const f32x4 o = (y * rs * lg + lb + bon[q] * v4) * g4;
                u32x2 w; w.x = cvtpk(o[0], o[1]); w.y = cvtpk(o[2], o[3]);
                *(u32x2*)(HN + (size_t)t * DM + 512 + c) = w; } }
    }
    GSYNC();

    if (PH(5)) { PHASE_IDS;
        pg8::Gemm g{HN, W_OUT0, 1024, 1024, 1024}; pg8::Sched S; S.init(192, 4, G, bx, (size_t)256 * 2048, (size_t)256 * 2048, 1 << 20, 0);
        pg8::EpiStore E{RAWB, 1024, 0, 1.f}; pg8::gemm_phase<pg8::EpiStore, 0>(lds, g, S, E);
    }
    GSYNC();
    { PHASE_IDS; for (int m = gw; m < T; m += 2 * NGW) row_item2(xin_row(x_prompt, x_sample, m), xin_row(x_prompt, x_sample, m + NGW), RAWB + (size_t)m * DM, RAWB + (size_t)(m + NGW) * DM, getargs()->in[3], getargs()->out + (size_t)m * DM, getargs()->out + (size_t)(m + NGW) * DM, getargs()->in[27], HN + (size_t)m * DM, HN + (size_t)(m + NGW) * DM, lane); }
    GSYNC();

#pragma unroll 1
    for (int layer = 0; layer < 2; ++layer) {
        if (layer == 1) {
            REP(10) if (PH(10)) { PHASE_IDS; pg8::Gemm g{HN, W_QKV, 1024, 1024, 1024}; pg8::Sched S; S.init(192, 12, G, bx, (size_t)256 * 2048, (size_t)256 * 2048, 1 << 20, 0);
              pg8::EpiQkv E{ROPEC, ROPES, QB}; pg8::gemm_phase<pg8::EpiQkv, 0>(lds, g, S, E); }
            GSYNC();
            REP(11) if (PH(11)) {
                char* alds = (char*)lds_raw;
                for (int un = blockIdx.x; un < 1536; un += gridDim.x) {
                    int qrow0, h, kv0, seq;
                    if (un < 512) { h = un & 7; qrow0 = (un >> 3) * 256; kv0 = 0; seq = TPR; }
                    else { const int v = un - 512; h = v & 7; const int qb = v >> 3; qrow0 = TPR + qb * 256; kv0 = TPR + (qb >> 4) * SL; seq = SL; }
#pragma unroll 1
                    for (int c = 0; c < 2; ++c) {
                        f32x16 o[4]; float l_reg;
                        __syncthreads();
                        att::attn_pass(QB + (size_t)qrow0 * 1024 + h * 128 + c * 64, KB + (size_t)kv0 * 1024 + h * 128 + c * 64, VB + (size_t)kv0 * 1024 + h * 128, seq, alds, o, l_reg);
                        int tid2 = threadIdx.x; asm volatile("" : "+v"(tid2));
                        const int tidq = tid2, laneq = tidq & 63, r32 = laneq & 31, hi = laneq >> 5;
                        float* wsl = (float*)(alds + 2 * att::SHM_V + 2 * att::SHM_K) + (tidq >> 6) * 64;
                        float* tmp = (float*)(WSB + WS_ATMP) + (size_t)blockIdx.x * (64 * 512);
                        if (hi == 0) wsl[r32] = l_reg; asm volatile("s_waitcnt lgkmcnt(0)" ::: "memory");
                        float rli[16];
#pragma unroll
                        for (int r = 0; r < 16; ++r) rli[r] = __builtin_amdgcn_rcpf(wsl[att::crow(r, hi)]);
                        if (c == 0) {
#pragma unroll
                            for (int d0 = 0; d0 < 4; ++d0) { float* tp = tmp + d0 * 8192 + tidq;
#pragma unroll
                                for (int r = 0; r < 16; ++r) tp[r * 512] = o[d0][r] * rli[r];
                                __builtin_amdgcn_sched_barrier(0); }
                        } else {
                            const float l1 = wave_sum(getargs()->in[21][laneq] * getargs()->in[22][laneq]), l2 = wave_sum(getargs()->in[23][laneq] * getargs()->in[24][laneq]);
                            const float lam = __expf(l1) - __expf(l2) + LAMBDA_INIT;
                            float ssq[16];
#pragma unroll
                            for (int r = 0; r < 16; ++r) ssq[r] = 0.f;
#pragma unroll
                            for (int d0 = 0; d0 < 4; ++d0) { const float* tp = tmp + d0 * 8192 + tidq;
#pragma unroll
                                for (int r = 0; r < 16; ++r) { const float v = tp[r * 512] - lam * (o[d0][r] * rli[r]); o[d0][r] = v; ssq[r] += v * v; }
                                __builtin_amdgcn_sched_barrier(0); }
#pragma unroll
                            for (int r = 0; r < 16; ++r) { float s = ssq[r]; s += __shfl_xor(s, 1); s += __shfl_xor(s, 2); s += __shfl_xor(s, 4); s += __shfl_xor(s, 8); s += __shfl_xor(s, 16);
                                ssq[r] = rsqrtf(s * (1.f / 128.f) + 1e-5f) * (1.f - LAMBDA_INIT); }
                            bf16_t* Ow = HN + (size_t)(qrow0 + (tidq >> 6) * 32) * DM + h * 128;
#pragma unroll
                            for (int d0 = 0; d0 < 4; ++d0) { const float gsub = getargs()->in[25][d0 * 32 + r32]; bf16_t* op = Ow + (size_t)(4 * hi) * DM + d0 * 32 + r32;
#pragma unroll
                                for (int r = 0; r < 16; ++r) op[((r & 3) + 8 * (r >> 2)) * DM] = f2bf(o[d0][r] * ssq[r] * gsub);
                                __builtin_amdgcn_sched_barrier(0); }
                        }
                    }
                }
                __syncthreads();
            }
            GSYNC();
            if (PH(12)) { PHASE_IDS; pg8::Gemm g{HN, W_O, 1024, 1024, 1024}; pg8::Sched S; S.init(192, 4, G, bx, (size_t)256 * 2048, (size_t)256 * 2048, 1 << 20, 0);
              pg8::EpiStore E{RAWB, 1024, 0, 1.f}; pg8::gemm_phase<pg8::EpiStore, 0>(lds, g, S, E); }
            GSYNC();
            { PHASE_IDS; for (int m = gw; m < T; m += 2 * NGW) row_item2(getargs()->out + (size_t)m * DM, getargs()->out + (size_t)(m + NGW) * DM, RAWB + (size_t)m * DM, RAWB + (size_t)(m + NGW) * DM, getargs()->in[19], getargs()->out + (size_t)m * DM, getargs()->out + (size_t)(m + NGW) * DM, getargs()->in[27] + DM, HN + (size_t)m * DM, HN + (size_t)(m + NGW) * DM, lane); }
            GSYNC();
        }
        REP(7) if (PH(7)) { PHASE_IDS; pg8::Gemm g{HN - DM, W_UP + (size_t)layer * NUP * 1024, 1024, 1024, 1024}; pg8::Sched S; S.init(199, 22, G, bx, (size_t)248 * 2048, (size_t)256 * 2048, 1 << 20, 0);
          pg8::EpiUp E{getargs()->in[30] + (size_t)layer * 3 * NUP, getargs()->in[31] + (size_t)layer * NUP, ACT}; pg8::gemm_phase<pg8::EpiUp, 1>(lds, g, S, E); }
        GSYNC();
        REP(8) if (PH(8)) { PHASE_IDS; pg8::Gemm g{ACT, W_DN + (size_t)layer * 1024 * FF, FF, FF, FF}; pg8::Sched S; S.init(192, 4, G, bx, (size_t)256 * FF * 2, (size_t)256 * FF * 2, 1 << 20, 0);
          pg8::EpiStore E{HN, 1024, 0, 1.f}; pg8::gemm_phase<pg8::EpiStore, 0>(lds, g, S, E); }
        GSYNC();
        { PHASE_IDS; for (int m = gw; m < T; m += 2 * NGW) row_item2(getargs()->out + (size_t)m * DM, getargs()->out + (size_t)(m + NGW) * DM, HN + (size_t)m * DM, HN + (size_t)(m + NGW) * DM, getargs()->in[28] + layer * DM, getargs()->out + (size_t)m * DM, getargs()->out + (size_t)(m + NGW) * DM, layer == 0 ? getargs()->in[18] : nullptr, HN + (size_t)m * DM, HN + (size_t)(m + NGW) * DM, lane); }
        if (layer == 0) GSYNC();
    }
}

extern "C" void kernel_launch(void* const* d_in, const int* in_sizes, int n_in, void* d_out, int out_size, void* d_ws, size_t ws_size, hipStream_t stream) {
    static int grid = 0;
    if (grid == 0) {
        if (n_in != 33 || out_size != T * DM || ws_size < WS_END) { fprintf(stderr, "kernel_launch: unexpected shapes: n_in %d out %d ws %zu (need %zu)\n", n_in, out_size, ws_size, (size_t)WS_END); grid = -1; return; }
        int dev = 0, cus = 0, per_cu = 0;
        hipGetDevice(&dev); hipDeviceGetAttribute(&cus, hipDeviceAttributeMultiprocessorCount, dev);
        if (hipFuncSetAttribute((const void*)fwd_mega, hipFuncAttributeMaxDynamicSharedMemorySize, LDS_BYTES) != hipSuccess) { fprintf(stderr, "kernel_launch: hipFuncSetAttribute failed\n"); grid = -1; return; }
        hipOccupancyMaxActiveBlocksPerMultiprocessor(&per_cu, (const void*)fwd_mega, 512, LDS_BYTES);
        (void)hipGetLastError();
        if (per_cu < 1) per_cu = 1;
        grid = cus;
        if (grid > NBLK) grid = NBLK;
    }
    if (grid < 0) return;
    Args a{};
    for (int i = 0; i < 33; ++i) a.in[i] = (const float*)d_in[i];
    a.out = (float*)d_out; a.ws = (unsigned char*)d_ws;
    void* args[] = {&a};
    hipError_t e = hipLaunchCooperativeKernel((const void*)fwd_mega, dim3(grid), dim3(512), args, LDS_BYTES, stream);
    if (e != hipSuccess) fprintf(stderr, "kernel_launch: cooperative launch failed: %s (grid %d)\n", hipGetErrorString(e), grid);
}
```
